# Optimizing an MI355X kernel written in HIP

```python
import jax, jax.numpy as jnp
from jax import lax
import numpy as np

D_MODEL = 1024
BATCH = 2
SEQ = 8192
DEPTH = 2

N_MIXERS = 2
N_POOL_LAYERS = (DEPTH + N_MIXERS - 1) // N_MIXERS
N_MLA_LAYERS = DEPTH // N_MIXERS
EXPAND = 2
POOL_WIDTH = EXPAND * D_MODEL
POOL_WINDOWS = (2, 4, 8, 16)
N_POOL_GROUPS = len(POOL_WINDOWS)
POOL_GROUP = POOL_WIDTH // N_POOL_GROUPS
N_HEADS = 16
QK_NOPE_DIM = 128
QK_ROPE_DIM = 64
QK_HEAD_DIM = QK_NOPE_DIM + QK_ROPE_DIM
V_HEAD_DIM = 128
Q_LORA_RANK = 384
KV_LORA_RANK = 256
MLA_WIDTH = N_HEADS * V_HEAD_DIM
MLA_IN_WIDTH = Q_LORA_RANK + KV_LORA_RANK + QK_ROPE_DIM + MLA_WIDTH
ROPE_THETA = 10000.0
Q_BLOCK = 128
EPS = 1e-6

kernel_name = "interleaved_pool_mla_gated_trunk"


def rmsnorm(x, g):
    xf = x.astype(jnp.float32)
    inv = lax.rsqrt(jnp.mean(xf * xf, axis=-1, keepdims=True) + EPS)
    return (xf * inv).astype(x.dtype) * g


def causal_window_mean(u, w):
    S = u.shape[1]
    cs = jnp.cumsum(u.astype(jnp.float32), axis=1)
    shifted = jnp.pad(cs, ((0, 0), (w, 0), (0, 0)))[:, :S]
    count = jnp.minimum(jnp.arange(1, S + 1), w).astype(jnp.float32)
    return ((cs - shifted) / count[None, :, None]).astype(u.dtype)


def pool_layer(x, norm_g, w_in, w_group, scale, w_out):
    B, S, _ = x.shape
    h = rmsnorm(x, norm_g)
    uz = h @ w_in
    u, z = uz[..., :POOL_WIDTH], uz[..., POOL_WIDTH:]
    ug = u.reshape(B, S, N_POOL_GROUPS, POOL_GROUP)
    pooled = jnp.stack([causal_window_mean(ug[:, :, g], w)
                        for g, w in enumerate(POOL_WINDOWS)], axis=2) - ug
    mixed = jnp.einsum('bsgc,gcd->bsgd', pooled, w_group).reshape(B, S, POOL_WIDTH) * scale
    y = mixed * jax.nn.silu(z)
    return x + y @ w_out


def rope_tables(positions, dtype):
    inv_freq = 1.0 / (ROPE_THETA ** (jnp.arange(0, QK_ROPE_DIM, 2, dtype=jnp.float32) / QK_ROPE_DIM))
    ang = positions.astype(jnp.float32)[..., None] * inv_freq
    return jnp.cos(ang).astype(dtype), jnp.sin(ang).astype(dtype)


def apply_rope(t, cos, sin):
    half = QK_ROPE_DIM // 2
    t1, t2 = t[..., :half], t[..., half:]
    return jnp.concatenate([t1 * cos - t2 * sin, t2 * cos + t1 * sin], axis=-1)


def causal_mla_attention(q_nope, q_rope, k_nope, k_rope, v):
    B, S, H, _ = q_nope.shape
    nb = S // Q_BLOCK
    scale = QK_HEAD_DIM ** -0.5
    key_pos = jnp.arange(S)

    def to_blocks(t):
        return t.reshape(B, nb, Q_BLOCK, *t.shape[2:]).swapaxes(0, 1)

    def one_block(args):
        qn, qr, start = args
        s = (jnp.einsum('bqhd,bkhd->bhqk', qn, k_nope)
             + jnp.einsum('bqhr,bkr->bhqk', qr, k_rope)).astype(jnp.float32) * scale
        q_pos = start + jnp.arange(Q_BLOCK)
        mask = q_pos[:, None] >= key_pos[None, :]
        s = jnp.where(mask, s, jnp.finfo(jnp.float32).min)
        p = jax.nn.softmax(s, axis=-1).astype(v.dtype)
        return jnp.einsum('bhqk,bkhd->bqhd', p, v)

    starts = jnp.arange(nb, dtype=jnp.int32) * Q_BLOCK
    out = lax.map(one_block, (to_blocks(q_nope), to_blocks(q_rope), starts))
    return out.swapaxes(0, 1).reshape(B, S, H, V_HEAD_DIM)


def mla_layer(x, cos, sin, norm_g, w_in, q_norm_g, w_q_b, kv_norm_g, w_kv_b, w_out):
    B, S, _ = x.shape
    h = rmsnorm(x, norm_g)
    proj = h @ w_in
    o1 = Q_LORA_RANK
    o2 = o1 + KV_LORA_RANK
    o3 = o2 + QK_ROPE_DIM
    q_lat, kv_lat, k_rope, z = proj[..., :o1], proj[..., o1:o2], proj[..., o2:o3], proj[..., o3:]
    q = (rmsnorm(q_lat, q_norm_g) @ w_q_b).reshape(B, S, N_HEADS, QK_HEAD_DIM)
    q_nope, q_rope = q[..., :QK_NOPE_DIM], q[..., QK_NOPE_DIM:]
    kv = (rmsnorm(kv_lat, kv_norm_g) @ w_kv_b).reshape(B, S, N_HEADS, QK_NOPE_DIM + V_HEAD_DIM)
    k_nope, v = kv[..., :QK_NOPE_DIM], kv[..., QK_NOPE_DIM:]
    q_rope = apply_rope(q_rope, cos[:, :, None, :], sin[:, :, None, :])
    k_rope = apply_rope(k_rope, cos, sin)
    o = causal_mla_attention(q_nope, q_rope, k_nope, k_rope, v)
    y = o.reshape(B, S, MLA_WIDTH) * jax.nn.silu(z)
    return x + y @ w_out


def setup_inputs(seed: int = 0) -> dict:
    key = jax.random.key(seed)
    ks = jax.random.split(key, 16)
    nrm = jax.random.normal
    Lp, Lm = N_POOL_LAYERS, N_MLA_LAYERS
    x = nrm(ks[0], (BATCH, SEQ, D_MODEL), jnp.float32)
    positions = jnp.broadcast_to(jnp.arange(SEQ, dtype=jnp.int32)[None, :], (BATCH, SEQ))
    return {
        "x": x,
        "positions": positions,
        "pool_norm": 1.0 + 0.02 * nrm(ks[1], (Lp, D_MODEL), jnp.float32),
        "pool_w_in": nrm(ks[2], (Lp, D_MODEL, 2 * POOL_WIDTH), jnp.float32) * D_MODEL ** -0.5,
        "pool_w_group": nrm(ks[3], (Lp, N_POOL_GROUPS, POOL_GROUP, POOL_GROUP), jnp.float32) * POOL_GROUP ** -0.5,
        "pool_scale": 1.0 + 0.02 * nrm(ks[4], (Lp, POOL_WIDTH), jnp.float32),
        "pool_w_out": nrm(ks[5], (Lp, POOL_WIDTH, D_MODEL), jnp.float32) * POOL_WIDTH ** -0.5,
        "mla_norm": 1.0 + 0.02 * nrm(ks[6], (Lm, D_MODEL), jnp.float32),
        "mla_w_in": nrm(ks[7], (Lm, D_MODEL, MLA_IN_WIDTH), jnp.float32) * D_MODEL ** -0.5,
        "mla_q_norm": 1.0 + 0.02 * nrm(ks[8], (Lm, Q_LORA_RANK), jnp.float32),
        "mla_w_q_b": nrm(ks[9], (Lm, Q_LORA_RANK, N_HEADS * QK_HEAD_DIM), jnp.float32) * Q_LORA_RANK ** -0.5,
        "mla_kv_norm": 1.0 + 0.02 * nrm(ks[10], (Lm, KV_LORA_RANK), jnp.float32),
        "mla_w_kv_b": nrm(ks[11], (Lm, KV_LORA_RANK, N_HEADS * (QK_NOPE_DIM + V_HEAD_DIM)), jnp.float32) * KV_LORA_RANK ** -0.5,
        "mla_w_out": nrm(ks[12], (Lm, MLA_WIDTH, D_MODEL), jnp.float32) * MLA_WIDTH ** -0.5,
        "final_norm": 1.0 + 0.02 * nrm(ks[13], (D_MODEL,), jnp.float32),
    }


def reference(x, positions, pool_norm, pool_w_in, pool_w_group, pool_scale, pool_w_out,
              mla_norm, mla_w_in, mla_q_norm, mla_w_q_b, mla_kv_norm, mla_w_kv_b, mla_w_out,
              final_norm):
    cos, sin = rope_tables(positions, x.dtype)
    for i in range(DEPTH):
        j = i // N_MIXERS
        if i % N_MIXERS == 0:
            x = pool_layer(x, pool_norm[j], pool_w_in[j], pool_w_group[j], pool_scale[j], pool_w_out[j])
        else:
            x = mla_layer(x, cos, sin, mla_norm[j], mla_w_in[j], mla_q_norm[j], mla_w_q_b[j],
                          mla_kv_norm[j], mla_w_kv_b[j], mla_w_out[j])
    return rmsnorm(x, final_norm)
```

```cpp
#include <hip/hip_runtime.h>
#include <hip/hip_bf16.h>
#include <hip/hip_cooperative_groups.h>
#include <cstdio>
#include <cstdint>
namespace cg = cooperative_groups;
#ifndef N_LAUNCH_MODE
#define N_LAUNCH_MODE 0
#endif

using bf16 = __hip_bfloat16;
typedef short bf16x8 __attribute__((ext_vector_type(8)));
typedef short s16x4 __attribute__((ext_vector_type(4)));
typedef float f32x16 __attribute__((ext_vector_type(16)));
typedef float f32x4 __attribute__((ext_vector_type(4)));
typedef unsigned u32x4 __attribute__((ext_vector_type(4)));
typedef unsigned u32x2 __attribute__((ext_vector_type(2)));

constexpr int NB = 2, S = 8192, T = NB * S, DM = 1024, PW = 2048, NH = 16;
constexpr int QL = 384, KVL = 256, DR = 64, DN = 128, DQK = 192, DV = 128;
constexpr int MLA_IN = QL + KVL + DR + PW;
constexpr int LATW = QL + KVL;
constexpr float EPS = 1e-6f;

constexpr size_t MiB = 1u << 20;
constexpr size_t WS_WIN1 = 0;
constexpr size_t WS_WQ   = 5 * MiB + MiB / 2;
constexpr size_t WS_WKV  = 7 * MiB + 3 * MiB / 4;
constexpr size_t WS_WO1  = 9 * MiB + 3 * MiB / 4;
constexpr size_t WS_COS  = 14 * MiB;
constexpr size_t WS_SIN  = 16 * MiB;
constexpr size_t WS_WIN0 = 18 * MiB;
constexpr size_t WS_WG   = 26 * MiB;
constexpr size_t WS_WO0  = 28 * MiB;
constexpr size_t WS_H0   = 32 * MiB;
constexpr size_t WS_U    = 64 * MiB;
constexpr size_t WS_SZ   = 128 * MiB;
constexpr size_t WS_PL   = 192 * MiB;
constexpr size_t WS_H1   = 18 * MiB;
constexpr size_t WS_QN   = 50 * MiB;
constexpr size_t WS_KVN  = 62 * MiB;
constexpr size_t WS_KR   = 70 * MiB;
constexpr size_t WS_O    = 72 * MiB;
constexpr size_t WS_QB   = 136 * MiB;
constexpr size_t WS_KB   = 184 * MiB;
constexpr size_t WS_VB   = 216 * MiB;
constexpr size_t WS_SS1  = 248 * MiB;
constexpr size_t WS_SSQ  = 248 * MiB + MiB / 2;
constexpr size_t WS_SSK  = 249 * MiB;
constexpr size_t WS_BAR  = 13 * MiB + 7 * MiB / 8;
constexpr size_t WS_END  = 256 * MiB;

struct Params {
  const float* x; const int* pos;
  const float* pool_norm; const float* pool_w_in; const float* pool_w_group; const float* pool_scale; const float* pool_w_out;
  const float* mla_norm; const float* mla_w_in; const float* mla_q_norm; const float* mla_w_q_b; const float* mla_kv_norm;
  const float* mla_w_kv_b; const float* mla_w_out; const float* final_norm;
  float* out; unsigned char* ws;
};

__device__ __forceinline__ unsigned cvtpk(float lo, float hi) {
  unsigned r; asm volatile("v_cvt_pk_bf16_f32 %0, %1, %2" : "=v"(r) : "v"(lo), "v"(hi)); return r;
}
__device__ __forceinline__ unsigned short f2bf(float v) { return (unsigned short)(cvtpk(v, v) & 0xffffu); }
__device__ __forceinline__ float bf2f(unsigned short h) { return __uint_as_float(((unsigned)h) << 16); }
__device__ __forceinline__ bf16x8 pack8(f32x4 a, f32x4 b) {
  u32x4 w = {cvtpk(a[0], a[1]), cvtpk(a[2], a[3]), cvtpk(b[0], b[1]), cvtpk(b[2], b[3])};
  return *reinterpret_cast<bf16x8*>(&w);
}
__device__ __forceinline__ float silu_f(float z) { return z * __builtin_amdgcn_rcpf(1.f + __builtin_amdgcn_exp2f(-1.4426950408889634f * z)); }
__device__ __forceinline__ int phase_tid(int wave_s) {
  int lane; asm volatile("v_mbcnt_lo_u32_b32 %0, -1, 0\n\tv_mbcnt_hi_u32_b32 %0, -1, %0" : "=v"(lane));
  return wave_s * 64 + lane;
}
#define DPP_F(v, ctrl) __int_as_float(__builtin_amdgcn_update_dpp(0, __float_as_int(v), ctrl, 0xF, 0xF, true))
__device__ __forceinline__ float half_sum(float v) {
  v += DPP_F(v, 0xB1); v += DPP_F(v, 0x4E); v += DPP_F(v, 0x141); v += DPP_F(v, 0x140);
  v += __int_as_float(__builtin_amdgcn_ds_swizzle(__float_as_int(v), 0x401F));
  return v;
}
__device__ __forceinline__ float dot8(f32x4 a, f32x4 b) { return a[0]*a[0] + a[1]*a[1] + a[2]*a[2] + a[3]*a[3] + b[0]*b[0] + b[1]*b[1] + b[2]*b[2] + b[3]*b[3]; }
__device__ __forceinline__ float wave_sum(float v) {
  v += DPP_F(v, 0xB1);
  v += DPP_F(v, 0x4E);
  v += DPP_F(v, 0x141);
  v += DPP_F(v, 0x140);
  v += __int_as_float(__builtin_amdgcn_ds_swizzle(__float_as_int(v), 0x401F));
  auto rr = __builtin_amdgcn_permlane32_swap(__float_as_uint(v), __float_as_uint(v), false, false);
  return __uint_as_float(rr[0]) + __uint_as_float(rr[1]);
}

constexpr int BM = 256, BK = 64, HALF = 128, NXCD = 8, WGM = 8, HT = HALF * BK;
constexpr int CT_LD = 260;
constexpr int GEMM_LDS = 128 * CT_LD * 4;
typedef f32x4 acc_t[2][2][4][2];

__device__ __forceinline__ int lds_byte(int r, int c) {
  int st = (r >> 4) * 2 + (c >> 5), rr = r & 15, cc = c & 31, ob = rr * 64 + cc * 2;
  return st * 1024 + (ob ^ (((ob >> 9) & 1) << 5));
}
__device__ __forceinline__ void stage_rc(int b, int& R, int& C) {
  int st = b / 1024, sb = b % 1024, swz = sb ^ (((sb >> 9) & 1) << 5);
  R = (st >> 1) * 16 + swz / 64; C = (st & 1) * 32 + (swz % 64) / 2;
}

struct Pre { f32x4 a, b; };
template <int K, int LDA, int LDB, bool SWAP = false>
__device__ __forceinline__ void gemm_main(const bf16* __restrict__ A, const bf16* __restrict__ Bt, int brow, int bcol, bf16* shm, int wave_s, acc_t& acc) {
#define SA(b, h) (shm + ((b) * 2 + (h)) * HT)
#define SB(b, h) (shm + (4 + (b) * 2 + (h)) * HT)
#define STAGE(P, BASE, LD, br, kt, OFF) do { const bf16* _gb = (BASE) + ((long)(br) * (LD) + (long)(kt) * BK); \
    __builtin_amdgcn_global_load_lds((const unsigned*)(_gb + OFF##0), (__attribute__((address_space(3))) unsigned*)((char*)(P) + tid * 16), 16, 0, 0); \
    __builtin_amdgcn_global_load_lds((const unsigned*)(_gb + OFF##1), (__attribute__((address_space(3))) unsigned*)((char*)(P) + tid * 16 + 8192), 16, 0, 0); } while (0)
#define STA(P, br, kt) STAGE(P, A, LDA, br, kt, offA)
#define STB(P, br, kt) STAGE(P, Bt, LDB, br, kt, offB)
#define LDA_(dst, b, h) for (int m = 0; m < 4; ++m) for (int k = 0; k < 2; ++k) \
    dst[m][k] = *reinterpret_cast<const bf16x8*>((char*)SA(b, h) + lds_byte(wr * 64 + m * 16 + fr, k * 32 + fq * 8))
#define LDB_(dst, b, h) for (int n = 0; n < 2; ++n) for (int k = 0; k < 2; ++k) \
    dst[n][k] = *reinterpret_cast<const bf16x8*>((char*)SB(b, h) + lds_byte(wc * 32 + n * 16 + fr, k * 32 + fq * 8))
#define MMA(ai, bj, At_, Bt_) do { __builtin_amdgcn_s_setprio(1); \
    for (int m = 0; m < 4; ++m) for (int n = 0; n < 2; ++n) for (int k = 0; k < 2; ++k) \
      acc[ai][bj][m][n] = SWAP ? __builtin_amdgcn_mfma_f32_16x16x32_bf16(Bt_[n][k], At_[m][k], acc[ai][bj][m][n], 0, 0, 0) \
                               : __builtin_amdgcn_mfma_f32_16x16x32_bf16(At_[m][k], Bt_[n][k], acc[ai][bj][m][n], 0, 0, 0); \
    __builtin_amdgcn_s_setprio(0); } while (0)
#define WAIT_V(n) asm volatile("s_waitcnt vmcnt(" #n ")" ::: "memory")
#define WAIT_L(n) asm volatile("s_waitcnt lgkmcnt(" #n ")" ::: "memory")
#define BAR __builtin_amdgcn_s_barrier()
#define SCHED __builtin_amdgcn_sched_barrier(0)
  static_assert(K % 128 == 0 && K >= 256, "K");
  const int tid = phase_tid(wave_s);
  const int wid = tid >> 6, lane = tid & 63, wr = wid >> 2, wc = wid & 3, fr = lane & 15, fq = lane >> 4;
  unsigned offA0, offA1, offB0, offB1;
  { int _r, _c; stage_rc(tid * 16, _r, _c); offA0 = _r * LDA + _c; offB0 = _r * LDB + _c;
    stage_rc(tid * 16 + 8192, _r, _c); offA1 = _r * LDA + _c; offB1 = _r * LDB + _c; }
#pragma unroll
  for (int a_ = 0; a_ < 2; ++a_) for (int b_ = 0; b_ < 2; ++b_) for (int m_ = 0; m_ < 4; ++m_) for (int n_ = 0; n_ < 2; ++n_) acc[a_][b_][m_][n_] = f32x4{};
  bf16x8 At[4][2], B0[2][2], B1[2][2];
  int nt = K / BK; asm volatile("" : "+s"(nt));
  STB(SB(0, 0), bcol, 0); STA(SA(0, 0), brow, 0);
  STB(SB(0, 1), bcol + HALF, 0); STA(SA(0, 1), brow + HALF, 0);
  if (wr == 1) BAR;
  WAIT_V(4); BAR;
  STB(SB(1, 0), bcol, 1); STA(SA(1, 0), brow, 1); STB(SB(1, 1), bcol + HALF, 1);
  WAIT_V(6); BAR;
#pragma nounroll
  for (int t = 0; t < nt - 2; t += 2) {
    LDB_(B0, 0, 0); SCHED; LDA_(At, 0, 0); STA(SA(1, 1), brow + HALF, t + 1);
    WAIT_L(8); BAR; WAIT_L(0); MMA(0, 0, At, B0); BAR; SCHED;
    LDB_(B1, 0, 1); STB(SB(0, 0), bcol, t + 2);
    BAR; WAIT_L(0); MMA(0, 1, At, B1); BAR;
    LDA_(At, 0, 1); STA(SA(0, 0), brow, t + 2);
    BAR; WAIT_L(0); MMA(1, 0, At, B0); BAR; SCHED;
    STB(SB(0, 1), bcol + HALF, t + 2);
    WAIT_V(6); BAR; MMA(1, 1, At, B1); BAR;
    LDB_(B0, 1, 0); SCHED; LDA_(At, 1, 0); STA(SA(0, 1), brow + HALF, t + 2);
    WAIT_L(8); BAR; WAIT_L(0); MMA(0, 0, At, B0); BAR; SCHED;
    LDB_(B1, 1, 1); STB(SB(1, 0), bcol, t + 3);
    BAR; WAIT_L(0); MMA(0, 1, At, B1); BAR;
    LDA_(At, 1, 1); STA(SA(1, 0), brow, t + 3);
    BAR; WAIT_L(0); MMA(1, 0, At, B0); BAR; SCHED;
    STB(SB(1, 1), bcol + HALF, t + 3);
    WAIT_V(6); BAR; MMA(1, 1, At, B1); BAR;
  }
  { LDB_(B0, 0, 0); LDA_(At, 0, 0); STA(SA(1, 1), brow + HALF, nt - 1);
    BAR; WAIT_L(0); MMA(0, 0, At, B0); BAR;
    LDB_(B1, 0, 1); BAR; WAIT_L(0); MMA(0, 1, At, B1); BAR;
    LDA_(At, 0, 1); WAIT_V(4); BAR; WAIT_L(0); MMA(1, 0, At, B0); MMA(1, 1, At, B1); BAR; }
  { LDB_(B0, 1, 0); LDA_(At, 1, 0); WAIT_V(2); BAR; WAIT_L(0); MMA(0, 0, At, B0); BAR;
    LDB_(B1, 1, 1); WAIT_V(0); BAR; WAIT_L(0); MMA(0, 1, At, B1); BAR;
    LDA_(At, 1, 1); BAR; WAIT_L(0); MMA(1, 0, At, B0); MMA(1, 1, At, B1); BAR; }
  if (wr == 0) BAR;
#undef SA
#undef SB
#undef STAGE
#undef STA
#undef STB
#undef LDA_
#undef LDB_
#undef MMA
#undef WAIT_V
#undef WAIT_L
#undef BAR
#undef SCHED
}
#define CT_DUMP(ai) do { \
    _Pragma("unroll") for (int bj = 0; bj < 2; ++bj) _Pragma("unroll") for (int m = 0; m < 4; ++m) _Pragma("unroll") for (int n = 0; n < 2; ++n) \
      *(f32x4*)(ct + ctw + (m * 16) * CT_LD + bj * 128 + n * 16) = acc[ai][bj][m][n]; } while (0)
template <int K, int LDA, int LDB, class CPreF, class PreF, class Epi>
__device__ __forceinline__ void gemm_tile(const bf16* __restrict__ A, const bf16* __restrict__ Bt, int brow, int bcol, bf16* shm, int wave_s, CPreF cpre, PreF pre, Epi epi) {
  acc_t acc;
  gemm_main<K, LDA, LDB, true>(A, Bt, brow, bcol, shm, wave_s, acc);
  float* ct = (float*)shm;
  const int tid2 = phase_tid(wave_s);
  const int ctw = (((tid2 >> 8) & 1) * 64 + (tid2 & 15)) * CT_LD + ((tid2 >> 6) & 3) * 32 + ((tid2 >> 4) & 3) * 4;
  const int ecc = (tid2 & 31) * 8, erow = tid2 >> 5;
  const Pre cpv = cpre(bcol + ecc);
#define CT_PRE(PV, ai) do { _Pragma("unroll") for (int it = 0; it < 8; ++it) PV[it] = pre(brow + (ai) * 128 + it * 16 + erow, bcol + ecc); } while (0)
#define CT_FIN(PV, ai) do { _Pragma("unroll") for (int it = 0; it < 8; ++it) { const int row = it * 16 + erow; const float* cp_ = ct + row * CT_LD + ecc; \
      const f32x4 lo = *(const f32x4*)cp_, hi = *(const f32x4*)(cp_ + 4); \
      epi(brow + (ai) * 128 + row, bcol + ecc, lo, hi, cp_, cpv, PV[it]); } } while (0)
  Pre pvA[8], pvB[8];
  CT_PRE(pvA, 0);
  CT_DUMP(0);
  __syncthreads();
  CT_PRE(pvB, 1);
  CT_FIN(pvA, 0);
  __syncthreads();
  CT_DUMP(1);
  __syncthreads();
  CT_FIN(pvB, 1);
  __syncthreads();
#undef CT_PRE
#undef CT_FIN
}
template <class BarF>
__device__ __forceinline__ void final_tile(bool active, const bf16* __restrict__ A, const bf16* __restrict__ Bt, int brow, int bcol, bf16* shm, int wave_s,
                                           float* out, float* ss2, const float* __restrict__ gfin, BarF grid_bar) {
  f32x4 xl[2][8], xh[2][8];
  const int tid2 = phase_tid(wave_s);
  const int ctw = (((tid2 >> 8) & 1) * 64 + (tid2 & 15)) * CT_LD + ((tid2 >> 6) & 3) * 32 + ((tid2 >> 4) & 3) * 4;
  const int ecc = (tid2 & 31) * 8, erow = tid2 >> 5;
  if (active) {
    acc_t acc;
    gemm_main<PW, PW, PW, true>(A, Bt, brow, bcol, shm, wave_s, acc);
    float* ct = (float*)shm;
#pragma unroll
    for (int ai = 0; ai < 2; ++ai) {
      f32x4 pa[8], pb[8];
#pragma unroll
      for (int it = 0; it < 8; ++it) { const float* d = out + (size_t)(brow + ai * 128 + it * 16 + erow) * DM + bcol + ecc; pa[it] = *(const f32x4*)d; pb[it] = *(const f32x4*)(d + 4); }
      CT_DUMP(ai);
      __syncthreads();
#pragma unroll
      for (int it = 0; it < 8; ++it) { const int row = it * 16 + erow; const float* cp_ = ct + row * CT_LD + ecc;
        xl[ai][it] = pa[it] + *(const f32x4*)cp_; xh[ai][it] = pb[it] + *(const f32x4*)(cp_ + 4);
        const float sq = half_sum(dot8(xl[ai][it], xh[ai][it]));
        if (ecc == 0) ss2[(size_t)(brow + ai * 128 + row) * 4 + (bcol >> 8)] = sq; }
      __syncthreads();
    }
  }
  grid_bar();
  if (active) {
    const f32x4 g0 = *(const f32x4*)(gfin + bcol + ecc), g1 = *(const f32x4*)(gfin + bcol + ecc + 4);
#pragma unroll
    for (int ai = 0; ai < 2; ++ai) {
      float inv[8];
#pragma unroll
      for (int it = 0; it < 8; ++it) { const f32x4 s4 = *(const f32x4*)(ss2 + (size_t)(brow + ai * 128 + it * 16 + erow) * 4); inv[it] = rsqrtf((s4[0] + s4[1] + s4[2] + s4[3]) * (1.f / DM) + EPS); }
#pragma unroll
      for (int it = 0; it < 8; ++it) { float* d = out + (size_t)(brow + ai * 128 + it * 16 + erow) * DM + bcol + ecc;
        *(f32x4*)d = xl[ai][it] * inv[it] * g0; *(f32x4*)(d + 4) = xh[ai][it] * inv[it] * g1; }
    }
  }
}
#define UNR _Pragma("unroll")
#define NOPRE [&](int, int) { return Pre{}; }
#define NOCPRE [&](int) { return Pre{}; }
#define EPI_ARGS int row, int col, f32x4 lo, f32x4 hi, const float* ctp, const Pre& cp, const Pre& pv
__device__ __forceinline__ void tile_map(int w, int nM, int nN, int& pm, int& pn) {
  const int nwg = nM * nN;
  int q = nwg / NXCD, r = nwg % NXCD, xcd = w % NXCD, off = w / NXCD;
  int wgid = (xcd < r ? xcd * (q + 1) : r * (q + 1) + (xcd - r) * q) + off;
  int nig = WGM * nN, gid = wgid / nig, fm = gid * WGM, gsz = min(nM - fm, WGM);
  pm = fm + ((wgid % nig) % gsz); pn = (wgid % nig) / gsz;
}

constexpr float SM_SCALE = 0.07216878364870322f;
constexpr float THR = 8.f;
constexpr int NW = 8, QBLK = 32, KVBLK = 64, QB = NW * QBLK;
constexpr int SHM_V = KVBLK * DV * 2, SHM_K = KVBLK * DQK * 2;
constexpr int ATT_LDS = 2 * SHM_V + 2 * SHM_K + NW * 64 * 4;
constexpr int LDS_MAIN = GEMM_LDS > ATT_LDS ? GEMM_LDS : ATT_LDS;
constexpr int KROW = DQK * 2;
#define KSWZ(row, colB) ((row) * KROW + ((colB) ^ (((row) & 7) << 4)))
#define SBAR() __builtin_amdgcn_sched_barrier(0)
__device__ __forceinline__ int v_st(int k, int c) { const int kk = (k & ~0xC) | ((k & 4) << 1) | ((k & 8) >> 1); return ((kk >> 3) * 4 + (c >> 5)) * 512 + ((kk & 7) * 32 + (c & 31)) * 2; }
__device__ __forceinline__ int v_rd_base(int lane) { return ((lane & 3) << 3) | (((lane >> 2) & 3) << 6) | (((lane >> 4) & 1) << 5) | (((lane >> 5) & 1) << 8); }
constexpr int v_rd_off(int d0, int ks, int half) { return d0 * 512 + ks * 4096 + half * 2048; }
__device__ __forceinline__ int crow(int r, int hi) { return (r & 3) + 8 * (r >> 2) + 4 * hi; }

__device__ __forceinline__ void mask_tile(f32x16& p0, f32x16& p1, int dq) {
  const float NEG = -__builtin_inff();
#pragma unroll
  for (int r = 0; r < 16; ++r) {
    const int c = (r & 3) + 8 * (r >> 2);
    if (dq - c < 0) p0[r] = NEG;
    if (dq - c - 32 < 0) p1[r] = NEG;
  }
}
constexpr float THR2 = THR * 1.4426950408889634f;
__device__ __forceinline__ void partialSM(f32x16& p0, f32x16& p1, float& m_reg, float& alpha, bool first, f32x16& msp) {
  float pmax = p0[0];
#pragma unroll
  for (int r = 1; r < 16; ++r) pmax = fmaxf(pmax, p0[r]);
#pragma unroll
  for (int r = 0; r < 16; ++r) pmax = fmaxf(pmax, p1[r]);
  { auto rr = __builtin_amdgcn_permlane32_swap(__float_as_uint(pmax), __float_as_uint(pmax), false, false);
    pmax = fmaxf(__uint_as_float(rr[0]), __uint_as_float(rr[1])); }
  if (__builtin_expect(!first && __all(pmax <= THR2), 1)) { alpha = 1.f; }
  else { const float d = first ? pmax : fmaxf(pmax, 0.f); alpha = first ? 0.f : __builtin_amdgcn_exp2f(-d); m_reg += d;
#pragma unroll
    for (int r = 0; r < 16; ++r) { p0[r] -= d; p1[r] -= d; msp[r] = -m_reg; } }
#pragma unroll
  for (int r = 0; r < 16; ++r) p0[r] = __builtin_amdgcn_exp2f(p0[r]);
}
__device__ __forceinline__ void finishSM(f32x16& p0, f32x16& p1, float alpha, float& l_reg, bf16x8& pa0, bf16x8& pa1, bf16x8& pa2, bf16x8& pa3) {
#pragma unroll
  for (int r = 0; r < 16; ++r) p1[r] = __builtin_amdgcn_exp2f(p1[r]);
  float ps = 0;
#pragma unroll
  for (int r = 0; r < 16; ++r) ps += p0[r];
#pragma unroll
  for (int r = 0; r < 16; ++r) ps += p1[r];
  { auto rr = __builtin_amdgcn_permlane32_swap(__float_as_uint(ps), __float_as_uint(ps), false, false);
    ps = __uint_as_float(rr[0]) + __uint_as_float(rr[1]); }
  l_reg = l_reg * alpha + ps;
#define PK4(P, B_, OUT) do { unsigned a0 = cvtpk(P[B_+0], P[B_+1]), a1 = cvtpk(P[B_+2], P[B_+3]); \
    unsigned b0 = cvtpk(P[B_+4], P[B_+5]), b1 = cvtpk(P[B_+6], P[B_+7]); \
    auto r0 = __builtin_amdgcn_permlane32_swap(a0, b0, false, false); auto r1 = __builtin_amdgcn_permlane32_swap(a1, b1, false, false); \
    u32x4 w = {r0[0], r1[0], r0[1], r1[1]}; OUT = *reinterpret_cast<bf16x8*>(&w); } while (0)
  PK4(p0, 0, pa0); PK4(p0, 8, pa1); PK4(p1, 0, pa2); PK4(p1, 8, pa3);
#undef PK4
}
template <int KB, class F>
__device__ __forceinline__ void qkt(f32x16& p0, f32x16& p1, const int (&kb)[8], const bf16x8* qr, const f32x16& msp, F issue_dma) {
  constexpr int KOFF = KB * SHM_K;
#define KRD(dst, base, off) asm volatile("ds_read_b128 %0, %1 offset:%2" : "=&v"(dst) : "v"(base), "i"(off) : "memory")
#define KPAIR(d) KRD(ka##d, kb[(d) < 8 ? ((d) & 3) : (d) - 4], KOFF + ((d) < 8 ? ((d) >> 2) * 128 : 0)); KRD(kc##d, kb[(d) < 8 ? ((d) & 3) : (d) - 4], KOFF + ((d) < 8 ? ((d) >> 2) * 128 + 8192 : 4096))
#define KMMA(d) p0 = __builtin_amdgcn_mfma_f32_32x32x16_bf16(ka##d, qr[d], p0, 0, 0, 0); p1 = __builtin_amdgcn_mfma_f32_32x32x16_bf16(kc##d, qr[d], p1, 0, 0, 0)
#define KMMA0() p0 = __builtin_amdgcn_mfma_f32_32x32x16_bf16(ka0, qr[0], msp, 0, 0, 0); p1 = __builtin_amdgcn_mfma_f32_32x32x16_bf16(kc0, qr[0], msp, 0, 0, 0)
#define LW(n) asm volatile("s_waitcnt lgkmcnt(" #n ")" ::: "memory"); SBAR()
  bf16x8 ka0, ka1, ka2, ka3, ka4, ka5, ka6, ka7, ka8, ka9, ka10, ka11, kc0, kc1, kc2, kc3, kc4, kc5, kc6, kc7, kc8, kc9, kc10, kc11;
  KPAIR(0); KPAIR(1); KPAIR(2);
  issue_dma();
  KPAIR(3); LW(6); KMMA0();
  KPAIR(4); LW(6); KMMA(1);
  KPAIR(5); LW(6); KMMA(2);
  KPAIR(6); LW(6); KMMA(3);
  KPAIR(7); LW(6); KMMA(4);
  KPAIR(8); LW(6); KMMA(5);
  KPAIR(9); LW(6); KMMA(6);
  KPAIR(10); LW(6); KMMA(7);
  KPAIR(11); LW(6); KMMA(8);
  LW(4); KMMA(9); LW(2); KMMA(10); LW(0); KMMA(11);
#undef KRD
#undef KPAIR
#undef KMMA
#undef KMMA0
#undef LW
}
template <int VB>
__device__ __forceinline__ void pv_tile(f32x16* o, int vb0, bf16x8 pa0, bf16x8 pa1, bf16x8 pa2, bf16x8 pa3) {
#define TRRD(dst, off) asm volatile("ds_read_b64_tr_b16 %0, %1 offset:%2" : "=&v"(dst) : "v"(vb0), "i"(off) : "memory")
#define VRD8(P, d0) do { constexpr int b_ = VB * SHM_V + v_rd_off(d0, 0, 0); \
    TRRD(P##l0, b_); TRRD(P##h0, b_ + 2048); TRRD(P##l1, b_ + 4096); TRRD(P##h1, b_ + 6144); TRRD(P##l2, b_ + 8192); TRRD(P##h2, b_ + 10240); TRRD(P##l3, b_ + 12288); TRRD(P##h3, b_ + 14336); } while (0)
#define VMMA(P, d0) do { \
    o[d0] = __builtin_amdgcn_mfma_f32_32x32x16_bf16(pa0, (bf16x8){P##l0[0], P##l0[1], P##l0[2], P##l0[3], P##h0[0], P##h0[1], P##h0[2], P##h0[3]}, o[d0], 0, 0, 0); \
    o[d0] = __builtin_amdgcn_mfma_f32_32x32x16_bf16(pa1, (bf16x8){P##l1[0], P##l1[1], P##l1[2], P##l1[3], P##h1[0], P##h1[1], P##h1[2], P##h1[3]}, o[d0], 0, 0, 0); \
    o[d0] = __builtin_amdgcn_mfma_f32_32x32x16_bf16(pa2, (bf16x8){P##l2[0], P##l2[1], P##l2[2], P##l2[3], P##h2[0], P##h2[1], P##h2[2], P##h2[3]}, o[d0], 0, 0, 0); \
    o[d0] = __builtin_amdgcn_mfma_f32_32x32x16_bf16(pa3, (bf16x8){P##l3[0], P##l3[1], P##l3[2], P##l3[3], P##h3[0], P##h3[1], P##h3[2], P##h3[3]}, o[d0], 0, 0, 0); } while (0)
#define LW(n) asm volatile("s_waitcnt lgkmcnt(" #n ")" ::: "memory"); SBAR()
  s16x4 xl0, xl1, xl2, xl3, xh0, xh1, xh2, xh3, yl0, yl1, yl2, yl3, yh0, yh1, yh2, yh3;
  VRD8(x, 0); VRD8(y, 1); LW(8); VMMA(x, 0);
  VRD8(x, 2); LW(8); VMMA(y, 1);
  VRD8(y, 3); LW(8); VMMA(x, 2);
  LW(0); VMMA(y, 3);
#undef TRRD
#undef VRD8
#undef VMMA
#undef LW
}

struct BlockRef { const bf16* Q; const bf16* K; const bf16* KR; const bf16* V; bf16* O; const float* CS; const float* SN; int P0; };

#define LD8(p) (*reinterpret_cast<const bf16x8*>(p))
#define VMW() asm volatile("s_waitcnt vmcnt(0)" ::: "memory")
#define DMA_TILE(k0, bf) do { \
    _Pragma("unroll") for (int p_ = 0; p_ < 2; ++p_) \
      __builtin_amdgcn_global_load_lds((const unsigned*)(cur.K + (size_t)(k0) * DN + koff[p_]), (__attribute__((address_space(3))) unsigned*)(K_lds + (bf) * SHM_K + p_ * 8192 + tid * 16), 16, 0, 0); \
    __builtin_amdgcn_global_load_lds((const unsigned*)(cur.KR + (size_t)(k0) * DR + roff), (__attribute__((address_space(3))) unsigned*)(K_lds + (bf) * SHM_K + 16384 + tid * 16), 16, 0, 0); \
    _Pragma("unroll") for (int p_ = 0; p_ < 2; ++p_) \
      __builtin_amdgcn_global_load_lds((const unsigned*)(cur.V + (size_t)(k0) * DV + vofd[p_]), (__attribute__((address_space(3))) unsigned*)(V_lds + (bf) * SHM_V + p_ * 8192 + tid * 16), 16, 0, 0); } while (0)

__device__ __forceinline__ void attn_block(const BlockRef& cur, char* lds, int wave_s) {
  const int tid = phase_tid(wave_s);
  const int wid = __builtin_amdgcn_readfirstlane(tid >> 6), lane = tid & 63, r32 = lane & 31, hi = lane >> 5;
  unsigned koff[2], vofd[2], roff;
#pragma unroll
  for (int p = 0; p < 2; ++p) { const int b_ = p * 8192 + tid * 16, row = b_ >> 8, pos = (b_ & 255) >> 4;
    const int c = (pos & 8) | ((pos & 7) ^ (row & 7)); koff[p] = row * DN + c * 8; }
  { const int b_ = tid * 16, row = b_ >> 7, pos = (b_ & 127) >> 4; roff = row * DR + (pos ^ (row & 7)) * 8; }
#pragma unroll
  for (int p = 0; p < 2; ++p) { const int b_ = p * 8192 + tid * 16, sub = b_ >> 9, kk = (sub >> 2) * 8 + ((b_ & 511) >> 6), c = (sub & 3) * 32 + ((b_ & 63) >> 1);
    (void)kk; (void)c; vofd[p] = b_ >> 1; }
  char* V_lds = lds; char* K_lds = lds + 2 * SHM_V;
  const int NT = cur.P0 / KVBLK + 4;
  const int qlo = cur.P0 + wid * QBLK, qm = qlo + r32 - 4 * hi;
  float* ws = (float*)(lds + 2 * SHM_V + 2 * SHM_K) + wid * 64; float* li_l = ws, * al_l = ws + 32;
  const int vb0 = (int)(uintptr_t)V_lds + v_rd_base(lane);
  int kb[8];
#pragma unroll
  for (int dd = 0; dd < 4; ++dd) { const int x_ = (dd * 32 + hi * 16) ^ ((r32 & 7) << 4); kb[dd] = (int)(uintptr_t)K_lds + r32 * 256 + x_; kb[4 + dd] = (int)(uintptr_t)K_lds + 16384 + r32 * 128 + x_; }
  bf16x8 qr[12];
#pragma unroll
  for (int d0 = 0; d0 < 12; ++d0) qr[d0] = LD8(cur.Q + (size_t)(wid * QBLK + r32) * DQK + d0 * 16 + hi * 8);
  DMA_TILE(0, 0);
#pragma unroll
  for (int dd = 0; dd < 2; ++dd) {
    const float* cp = cur.CS + (size_t)(wid * QBLK + r32) * 32 + dd * 16 + hi * 8; const float* sp = cur.SN + (size_t)(wid * QBLK + r32) * 32 + dd * 16 + hi * 8;
    const f32x4 c0 = *(const f32x4*)cp, c1 = *(const f32x4*)(cp + 4), s0 = *(const f32x4*)sp, s1 = *(const f32x4*)(sp + 4);
    const bf16x8 qa = qr[8 + dd], qb = qr[10 + dd]; f32x4 na0, na1, nb0, nb1;
#pragma unroll
    for (int j = 0; j < 4; ++j) { const float a0 = bf2f((unsigned short)qa[j]), b0 = bf2f((unsigned short)qb[j]), a1 = bf2f((unsigned short)qa[4 + j]), b1 = bf2f((unsigned short)qb[4 + j]);
      na0[j] = a0 * c0[j] - b0 * s0[j]; nb0[j] = b0 * c0[j] + a0 * s0[j]; na1[j] = a1 * c1[j] - b1 * s1[j]; nb1[j] = b1 * c1[j] + a1 * s1[j]; }
    qr[8 + dd] = pack8(na0, na1); qr[10 + dd] = pack8(nb0, nb1); }
  VMW();
  __syncthreads();
  float m_reg = 0.f, l_reg = 0; f32x16 o[4] = {}; f32x16 msp = {};
#define RESC(a) do { if (__any((a) < 1.f)) { if (hi == 0) al_l[r32] = (a); asm volatile("s_waitcnt lgkmcnt(0)" ::: "memory"); \
    for (int d_ = 0; d_ < 4; ++d_) for (int r = 0; r < 16; ++r) o[d_][r] *= al_l[crow(r, hi)]; } } while (0)
#define STEP(t, KB) do { f32x16 p0, p1; float al; bf16x8 pa0, pa1, pa2, pa3; \
    SBAR(); qkt<KB>(p0, p1, kb, qr, msp, [&]() { if ((t) + 1 < NT) { DMA_TILE(((t) + 1) * KVBLK, 1 - KB); } }); \
    { const int kb_ = (t) * KVBLK; if (kb_ + KVBLK - 1 > qlo) mask_tile(p0, p1, qm - kb_); } \
    partialSM(p0, p1, m_reg, al, (t) == 0, msp); RESC(al); \
    finishSM(p0, p1, al, l_reg, pa0, pa1, pa2, pa3); SBAR(); \
    pv_tile<KB>(o, vb0, pa0, pa1, pa2, pa3); SBAR(); \
    VMW(); __syncthreads(); SBAR(); } while (0)
  for (int t = 0; t < NT; t += 2) { STEP(t, 0); STEP(t + 1, 1); }
  if (hi == 0) li_l[r32] = l_reg; asm volatile("s_waitcnt lgkmcnt(0)" ::: "memory");
  float rli[16];
#pragma unroll
  for (int r = 0; r < 16; ++r) rli[r] = __builtin_amdgcn_rcpf(li_l[crow(r, hi)]);
  bf16* Ow = cur.O + (size_t)(wid * QBLK) * PW;
  unsigned short* ost = (unsigned short*)(lds + wid * 8192);
#pragma unroll
  for (int r = 0; r < 16; ++r) { const int orow = crow(r, hi);
#pragma unroll
    for (int d0 = 0; d0 < 4; ++d0) ost[orow * 128 + d0 * 32 + r32] = f2bf(o[d0][r] * rli[r]); }
  asm volatile("s_waitcnt lgkmcnt(0)" ::: "memory");
#pragma unroll
  for (int i = 0; i < 8; ++i) { const int row = i * 4 + (lane >> 4), ch = lane & 15;
    *(bf16x8*)(Ow + (size_t)row * PW + ch * 8) = *(const bf16x8*)(ost + row * 128 + ch * 8); }
  __syncthreads();
#undef RESC
#undef STEP
}

__device__ __forceinline__ BlockRef att_ref(int b, int h, int qb, const bf16* Qb, const bf16* Kb, const bf16* Vb, const bf16* kr, bf16* O, const float* cs, const float* sn) {
  BlockRef r;
  r.Q = Qb + ((size_t)h * S + (size_t)qb * QB) * DQK;
  r.K = Kb + (size_t)h * S * DN; r.V = Vb + (size_t)h * S * DV; r.KR = kr + (size_t)b * S * DR;
  r.O = O + ((size_t)b * S + (size_t)qb * QB) * PW + h * DV; r.P0 = qb * QB;
  r.CS = cs + ((size_t)b * S + (size_t)qb * QB) * 32; r.SN = sn + ((size_t)b * S + (size_t)qb * QB) * 32;
  return r;
}
__device__ __forceinline__ void attn_phase(int b, const bf16* Qb, const bf16* Kb, const bf16* Vb, const bf16* kr, bf16* O, const float* cs, const float* sn, char* lds, int wave_s) {
  constexpr int total = NH * 32;
  for (int L = blockIdx.x; L < total; L += gridDim.x) {
    const int pass = L / (NH * 16), Lp = L % (NH * 16);
    const int xcd = Lp & 7, k = Lp >> 3, h = xcd * 2 + (k >> 4), x = k & 15;
    const int qb = pass ? x : 31 - x;
    const BlockRef cur = att_ref(b, h, qb, Qb, Kb, Vb, kr, O, cs, sn);
    attn_block(cur, lds, wave_s);
  }
}

__device__ __forceinline__ void tr_matrix(const float* __restrict__ src, int K, int N, bf16* __restrict__ dst, bool sw, float* tile, int& cursor, int wave_s) {
  (void)sw;
  const int tid = phase_tid(wave_s);
  const int nk = K / 64, nn = N / 64, ntile = nk * nn;
  int i = (blockIdx.x + gridDim.x - (cursor % gridDim.x)) % gridDim.x;
  cursor += ntile;
  const int lr = tid >> 4, lc4 = (tid & 15) * 4;
  f32x4 v0 = {}, v1 = {};
  if (i < ntile) { const float* p = src + (size_t)((i / nn) * 64 + lr) * N + (i % nn) * 64 + lc4; v0 = *(const f32x4*)p; v1 = *(const f32x4*)(p + (size_t)32 * N); }
  while (i < ntile) {
    const int k0 = (i / nn) * 64, n0 = (i % nn) * 64;
#pragma unroll
    for (int e = 0; e < 4; ++e) { tile[lr * 65 + lc4 + e] = v0[e]; tile[(lr + 32) * 65 + lc4 + e] = v1[e]; }
    __syncthreads();
    const int inext = i + gridDim.x;
    if (inext < ntile) { const float* p = src + (size_t)((inext / nn) * 64 + lr) * N + (inext % nn) * 64 + lc4; v0 = *(const f32x4*)p; v1 = *(const f32x4*)(p + (size_t)32 * N); }
    { const int n = tid >> 3, kk = (tid & 7) * 8;
      f32x4 a, b2;
      a[0] = tile[(kk + 0) * 65 + n]; a[1] = tile[(kk + 1) * 65 + n]; a[2] = tile[(kk + 2) * 65 + n]; a[3] = tile[(kk + 3) * 65 + n];
      b2[0] = tile[(kk + 4) * 65 + n]; b2[1] = tile[(kk + 5) * 65 + n]; b2[2] = tile[(kk + 6) * 65 + n]; b2[3] = tile[(kk + 7) * 65 + n];
      *(bf16x8*)(dst + (size_t)(n0 + n) * K + k0 + kk) = pack8(a, b2); }
    __syncthreads();
    i = inext;
  }
}
template <bool OUT_BF16>
__device__ __forceinline__ void rmsnorm_rows(const float* x, const float* __restrict__ g, bf16* out, float* outf, int wave_s) {
  const int tid_ = phase_tid(wave_s);
  const int wid = tid_ >> 6, lane = tid_ & 63;
  const int stride = gridDim.x * 8;
  int row = blockIdx.x * 8 + wid;
  f32x4 va[4], vb[4], na[4], nb[4];
#define RMS_LOAD(A_, B_, r_) do { const int r2_ = (r_) + stride; const f32x4* xa_ = (const f32x4*)(x + (size_t)(r_) * DM); const f32x4* xb_ = (const f32x4*)(x + (size_t)(r2_ < T ? r2_ : (r_)) * DM); \
    _Pragma("unroll") for (int i = 0; i < 4; ++i) A_[i] = xa_[lane + 64 * i]; _Pragma("unroll") for (int i = 0; i < 4; ++i) B_[i] = xb_[lane + 64 * i]; } while (0)
  if (row < T) RMS_LOAD(va, vb, row);
  while (row < T) {
    const int row2 = row + stride, rown = row + 2 * stride; const bool two = row2 < T;
    if (rown < T) RMS_LOAD(na, nb, rown);
    float sa = 0, sb = 0;
#pragma unroll
    for (int i = 0; i < 4; ++i) { sa += va[i][0] * va[i][0] + va[i][1] * va[i][1] + va[i][2] * va[i][2] + va[i][3] * va[i][3];
                                  sb += vb[i][0] * vb[i][0] + vb[i][1] * vb[i][1] + vb[i][2] * vb[i][2] + vb[i][3] * vb[i][3]; }
    sa = wave_sum(sa); sb = wave_sum(sb);
    const float ia = rsqrtf(sa * (1.f / DM) + EPS), ib = rsqrtf(sb * (1.f / DM) + EPS);
#pragma unroll
    for (int i = 0; i < 4; ++i) { const f32x4 gg = ((const f32x4*)g)[lane + 64 * i];
      const f32x4 wa = va[i] * ia * gg, wb = vb[i] * ib * gg;
      if constexpr (OUT_BF16) {
        u32x2 pa = {cvtpk(wa[0], wa[1]), cvtpk(wa[2], wa[3])}; *(u32x2*)(out + (size_t)row * DM + (lane + 64 * i) * 4) = pa;
        if (two) { u32x2 pb = {cvtpk(wb[0], wb[1]), cvtpk(wb[2], wb[3])}; *(u32x2*)(out + (size_t)row2 * DM + (lane + 64 * i) * 4) = pb; } }
      else { ((f32x4*)(outf + (size_t)row * DM))[lane + 64 * i] = wa; if (two) ((f32x4*)(outf + (size_t)row2 * DM))[lane + 64 * i] = wb; } }
#pragma unroll
    for (int i = 0; i < 4; ++i) { va[i] = na[i]; vb[i] = nb[i]; }
    row = rown;
  }
#undef RMS_LOAD
}
__device__ __forceinline__ void rmsnorm_rows_bf16(const float* __restrict__ x, const float* __restrict__ g, bf16* __restrict__ out, int wave_s) { rmsnorm_rows<true>(x, g, out, nullptr, wave_s); }
__device__ __forceinline__ void rmsnorm_rows_f32_inplace(float* x, const float* __restrict__ g, int wave_s) { rmsnorm_rows<false>(x, g, nullptr, x, wave_s); }
__device__ __forceinline__ void rope_tables(const int* __restrict__ pos, float* __restrict__ cs, float* __restrict__ sn, int wave_s) {
  const int tid_ = phase_tid(wave_s);
  for (int idx = blockIdx.x * 512 + tid_; idx < T * 32; idx += gridDim.x * 512) {
    const int t = idx >> 5, i = idx & 31;
    const float inv_freq = 1.0f / powf(10000.0f, (float)(2 * i) / 64.0f);
    const float ang = (float)pos[t] * inv_freq;
    cs[idx] = cosf(ang); sn[idx] = sinf(ang);
  }
}
__device__ __forceinline__ void pool_item(const bf16* __restrict__ u, bf16* __restrict__ pl, int cgx, int t0) {
  {
    const int s0 = t0 & (S - 1);
    const int w = 2 << (cgx >> 6);
    const bf16* up = u + (size_t)t0 * PW + cgx * 8;
    bf16* pp = pl + ((size_t)(cgx >> 6) * T + t0) * 512 + (cgx & 63) * 8;
    float s[8];
#pragma unroll
    for (int e = 0; e < 8; ++e) s[e] = 0.f;
    if (s0 > 0) {
#pragma unroll 4
      for (int d = 1; d <= w; ++d) { const bf16x8 v = LD8(up - (size_t)d * PW);
#pragma unroll
        for (int e = 0; e < 8; ++e) s[e] += bf2f((unsigned short)v[e]); } }
    bf16x8 cv[8], ov[8], cn[8], on[8];
#define POOL_LOAD(C_, O_, i0_) do { \
    _Pragma("unroll") for (int k = 0; k < 8; ++k) C_[k] = LD8(up + (size_t)((i0_) + k) * PW); \
    _Pragma("unroll") for (int k = 0; k < 8; ++k) { const int i = (i0_) + k; O_[k] = LD8(up + (size_t)((s0 + i - w >= 0) ? (i - w) : i) * PW); } } while (0)
    POOL_LOAD(cv, ov, 0);
#pragma unroll
    for (int i0 = 0; i0 < 32; i0 += 8) {
      if (i0 + 8 < 32) POOL_LOAD(cn, on, i0 + 8);
#pragma unroll
      for (int k = 0; k < 8; ++k) { const int i = i0 + k, si = s0 + i; const bool has = si - w >= 0;
        float c[8];
#pragma unroll
        for (int e = 0; e < 8; ++e) { c[e] = bf2f((unsigned short)cv[k][e]); s[e] += c[e]; if (has) s[e] -= bf2f((unsigned short)ov[k][e]); }
        const float rc = 1.f / (float)min(si + 1, w);
        f32x4 a = {s[0] * rc - c[0], s[1] * rc - c[1], s[2] * rc - c[2], s[3] * rc - c[3]};
        f32x4 b2 = {s[4] * rc - c[4], s[5] * rc - c[5], s[6] * rc - c[6], s[7] * rc - c[7]};
        *(bf16x8*)(pp + (size_t)i * 512) = pack8(a, b2); }
#pragma unroll
      for (int k = 0; k < 8; ++k) { cv[k] = cn[k]; ov[k] = on[k]; }
    }
#undef POOL_LOAD
  }
}
__device__ __forceinline__ void pool_phase(const bf16* __restrict__ u, bf16* __restrict__ pl, int wave_s) {
  const int tid_ = phase_tid(wave_s);
  for (int idx = blockIdx.x * 512 + tid_; idx < (T / 32) * 256; idx += gridDim.x * 512) pool_item(u, pl, idx & 255, (idx >> 8) * 32);
}
typedef const __attribute__((address_space(4))) Params* KParams;
#define XB_TMO      128
#define XB_XCNT(j)  (256  + 64 * (j))
#define XB_XSUB(j)  (1280 + 64 * (j))
#define XB_XGEN(j)  (2304 + 64 * (j))
#define XB_TOP      3328
#define XB_TOPGEN   3392
#define XCD_BAR_WORDS 3456
#define XB_SPIN_CAP (1u << 20)
#define LAS __attribute__((address_space(3)))
__device__ __forceinline__ unsigned xb_ld(unsigned* p)              { return __hip_atomic_load(p, __ATOMIC_RELAXED, __HIP_MEMORY_SCOPE_AGENT); }
__device__ __forceinline__ unsigned xb_add(unsigned* p, unsigned v) { return __hip_atomic_fetch_add(p, v, __ATOMIC_RELAXED, __HIP_MEMORY_SCOPE_AGENT); }
__device__ __forceinline__ unsigned xb_xcc_id() { return (unsigned)__builtin_amdgcn_s_getreg((3 << 11) | 20) & 0xFu; }
#define XB_SPIN(cond, bar) do { unsigned _sp = 0; while (cond) { __builtin_amdgcn_s_sleep(1); \
    if ((++_sp & 255u) == 0u) { if (xb_ld(&(bar)[XB_TMO])) break; if (_sp > XB_SPIN_CAP) { atomicAdd(&(bar)[XB_TMO], 1u); break; } } } } while (0)
__device__ __forceinline__ void xcd_barrier_complete(unsigned* bar, unsigned x, unsigned& nloc, unsigned& nx) {
  const unsigned G = gridDim.x;
  unsigned sum, cnt, mine, sp = 0u;
  for (;;) {
    sum = 0u; cnt = 0u; mine = 0u;
#pragma unroll
    for (unsigned j = 0; j < 16; ++j) { const unsigned c = xb_ld(&bar[XB_XCNT(j)]); sum += c; cnt += (c > 0u) ? 1u : 0u; mine = (j == x) ? c : mine; }
    if (sum == G) break;
    __builtin_amdgcn_s_sleep(1);
    if ((++sp & 255u) == 0u) { if (xb_ld(&bar[XB_TMO])) break; if (sp > XB_SPIN_CAP) { atomicAdd(&bar[XB_TMO], 1u); break; } }
  }
  nloc = mine > 0u ? mine : 1u; nx = cnt > 0u ? cnt : 1u;
}
__device__ __forceinline__ void xcd_barrier(unsigned* bar, volatile LAS unsigned* st, int wave_s) {
  asm volatile("s_waitcnt vmcnt(0)" ::: "memory");
  __syncthreads();
  if (phase_tid(wave_s) == 0) {
    const unsigned x = xb_xcc_id();
    __builtin_amdgcn_s_waitcnt(0);
    unsigned nloc = st[0], nx = st[1];
    if (nloc == 0u) { xcd_barrier_complete(bar, x, nloc, nx); st[0] = nloc; st[1] = nx; }
    const unsigned old = xb_add(&bar[XB_XSUB(x)], 1u);
    const unsigned gen = old / nloc;
    if (old + 1u == (gen + 1u) * nloc) {
      __builtin_amdgcn_fence(__ATOMIC_RELEASE, "agent");
      asm volatile("s_waitcnt vmcnt(0)" ::: "memory");
      const unsigned og = xb_add(&bar[XB_TOP], 1u);
      const unsigned tg = og / nx;
      if (og + 1u == (tg + 1u) * nx) xb_add(&bar[XB_TOPGEN], 1u);
      else XB_SPIN(xb_ld(&bar[XB_TOPGEN]) == tg, bar);
      __builtin_amdgcn_fence(__ATOMIC_ACQUIRE, "agent");
      xb_add(&bar[XB_XGEN(x)], 1u);
      asm volatile("s_waitcnt vmcnt(0)" ::: "memory");
    } else {
      XB_SPIN(xb_ld(&bar[XB_XGEN(x)]) == gen, bar);
      __builtin_amdgcn_fence(__ATOMIC_ACQUIRE, "agent");
      asm volatile("s_waitcnt vmcnt(0)" ::: "memory");
    }
  }
  __syncthreads();
}
#define PHASE_PTRS KParams P_ = kp; asm volatile("" : "+s"(P_)); Params p; p.x = P_->x; p.pos = P_->pos; p.pool_norm = P_->pool_norm; p.pool_w_in = P_->pool_w_in; p.pool_w_group = P_->pool_w_group; p.pool_scale = P_->pool_scale; p.pool_w_out = P_->pool_w_out; p.mla_norm = P_->mla_norm; p.mla_w_in = P_->mla_w_in; p.mla_q_norm = P_->mla_q_norm; p.mla_w_q_b = P_->mla_w_q_b; p.mla_kv_norm = P_->mla_kv_norm; p.mla_w_kv_b = P_->mla_w_kv_b; p.mla_w_out = P_->mla_w_out; p.final_norm = P_->final_norm; p.out = P_->out; p.ws = P_->ws; unsigned char* ws = p.ws; \
  bf16* w_in1 = (bf16*)(ws + WS_WIN1); bf16* w_q = (bf16*)(ws + WS_WQ); bf16* w_kv = (bf16*)(ws + WS_WKV); bf16* w_o1 = (bf16*)(ws + WS_WO1); \
  float* cs = (float*)(ws + WS_COS); float* sn = (float*)(ws + WS_SIN); \
  bf16* w_in0 = (bf16*)(ws + WS_WIN0); bf16* w_g = (bf16*)(ws + WS_WG); bf16* w_o0 = (bf16*)(ws + WS_WO0); \
  bf16* h0 = (bf16*)(ws + WS_H0); bf16* u = (bf16*)(ws + WS_U); bf16* yb = (bf16*)(ws + WS_U); bf16* sz = (bf16*)(ws + WS_SZ); bf16* pl = (bf16*)(ws + WS_PL); \
  bf16* h1 = (bf16*)(ws + WS_H1); bf16* qn = (bf16*)(ws + WS_QN); bf16* kvn = (bf16*)(ws + WS_KVN); bf16* kr = (bf16*)(ws + WS_KR); \
  bf16* ob = (bf16*)(ws + WS_O); bf16* Qb = (bf16*)(ws + WS_QB); bf16* Kb = (bf16*)(ws + WS_KB); bf16* Vb = (bf16*)(ws + WS_VB); \
  float* ss1 = (float*)(ws + WS_SS1); float* ssq = (float*)(ws + WS_SSQ); float* ssk = (float*)(ws + WS_SSK);

template <int MASK>
__global__ void __launch_bounds__(512, 2) fwd_kernel(Params p_unused, int b_arg) {
  constexpr bool FUSED = MASK == 0x3fff;
  extern __shared__ __attribute__((aligned(16))) char lds[];
  const int wave_s = __builtin_amdgcn_readfirstlane((int)threadIdx.x >> 6);
  volatile LAS unsigned* xb_st = (volatile LAS unsigned*)(lds + LDS_MAIN);
  KParams kp = (KParams)__builtin_amdgcn_kernarg_segment_ptr();
  if constexpr (FUSED) {
    unsigned* bar0 = (unsigned*)(kp->ws + WS_BAR);
    if (threadIdx.x == 0) { xb_st[0] = 0u; xb_st[1] = 0u;
      (void)xb_add(bar0 + XB_XCNT(xb_xcc_id()), 1u); }
    __syncthreads();
  }
  bf16* shm = (bf16*)lds;
  if constexpr ((MASK >> 0) & 1) { PHASE_PTRS
  { int cur = 0; float* tile = (float*)lds;
    tr_matrix(p.pool_w_in, DM, 2 * PW, w_in0, false, tile, cur, wave_s);
    for (int g = 0; g < 4; ++g) tr_matrix(p.pool_w_group + (size_t)g * 512 * 512, 512, 512, w_g + (size_t)g * 512 * 512, false, tile, cur, wave_s);
    tr_matrix(p.pool_w_out, PW, DM, w_o0, false, tile, cur, wave_s);
    tr_matrix(p.mla_w_in, DM, MLA_IN, w_in1, false, tile, cur, wave_s);
    tr_matrix(p.mla_w_q_b, QL, NH * DQK, w_q, false, tile, cur, wave_s);
    tr_matrix(p.mla_w_kv_b, KVL, NH * (DN + DV), w_kv, false, tile, cur, wave_s);
    tr_matrix(p.mla_w_out, PW, DM, w_o1, false, tile, cur, wave_s);
    rope_tables(p.pos, cs, sn, wave_s);
    rmsnorm_rows_bf16(p.x, p.pool_norm, h0, wave_s); }
  }
  if constexpr (FUSED) { KParams P_ = kp; asm volatile("" : "+s"(P_)); xcd_barrier((unsigned*)(P_->ws + WS_BAR), xb_st, wave_s); }
  if constexpr ((MASK >> 1) & 1) { PHASE_PTRS
  { constexpr int nM = T / 256, nN = (2 * PW) / 256;
    for (int w = blockIdx.x; w < nM * nN; w += gridDim.x) { int pm, pn; tile_map(w, nM, nN, pm, pn);
      gemm_tile<DM, DM, DM>(h0, w_in0, pm * 256, pn * 256, shm, wave_s, NOCPRE, NOPRE, [&](EPI_ARGS) {
        if (col < PW) *(bf16x8*)(u + (size_t)row * PW + col) = pack8(lo, hi);
        else { UNR for (int e = 0; e < 4; ++e) { lo[e] = silu_f(lo[e]); hi[e] = silu_f(hi[e]); }
          *(bf16x8*)(sz + (size_t)row * PW + col - PW) = pack8(lo, hi); } }); } }
  }
  if constexpr (FUSED) { KParams P_ = kp; asm volatile("" : "+s"(P_)); xcd_barrier((unsigned*)(P_->ws + WS_BAR), xb_st, wave_s); }
  if constexpr (!FUSED && ((MASK >> 2) & 1)) { PHASE_PTRS
  pool_phase(u, pl, wave_s);
  }
  if constexpr ((MASK >> 3) & 1) { PHASE_PTRS
  { const float* scale = p.pool_scale;
    constexpr int NU = FUSED ? 256 : 512;
    for (int w = blockIdx.x; w < NU; w += gridDim.x) {
      int g, pm, pn0, pn1;
      if constexpr (FUSED) { g = w >> 6; pm = w & 63; pn0 = 0; pn1 = 2;
        const int tid_ = phase_tid(wave_s);
        pool_item(u, pl, g * 64 + (tid_ & 63), (pm * 8 + (tid_ >> 6)) * 32);
        asm volatile("s_waitcnt vmcnt(0)" ::: "memory");
        __syncthreads(); }
      else { g = w >> 7; const int wi = w & 127; pm = wi >> 1; pn0 = wi & 1; pn1 = pn0 + 1; }
      for (int pn = pn0; pn < pn1; ++pn)
      gemm_tile<512, 512, 512>(pl + (size_t)g * T * 512, w_g + (size_t)g * 512 * 512, pm * 256, pn * 256, shm, wave_s,
        [&](int col) { Pre r; r.a = *(const f32x4*)(scale + g * 512 + col); r.b = *(const f32x4*)(scale + g * 512 + col + 4); return r; },
        [&](int row, int col) { Pre r; r.a = *(const f32x4*)(sz + (size_t)row * PW + g * 512 + col); r.b = f32x4{}; return r; },
        [&](EPI_ARGS) {
        const int c = g * 512 + col; const size_t ix = (size_t)row * PW + c;
        const bf16x8 zz = *reinterpret_cast<const bf16x8*>(&pv.a); const f32x4 s0 = cp.a, s1 = cp.b;
        UNR for (int e = 0; e < 4; ++e) { lo[e] *= s0[e] * bf2f((unsigned short)zz[e]); hi[e] *= s1[e] * bf2f((unsigned short)zz[4 + e]); }
        *(bf16x8*)(yb + ix) = pack8(lo, hi); }); } }
  }
  if constexpr (FUSED) { KParams P_ = kp; asm volatile("" : "+s"(P_)); xcd_barrier((unsigned*)(P_->ws + WS_BAR), xb_st, wave_s); }
  if constexpr ((MASK >> 4) & 1) { PHASE_PTRS
  { constexpr int nM = T / 256, nN = DM / 256; const float* x = p.x; float* out = p.out; const float* gm = p.mla_norm;
    for (int w = blockIdx.x; w < nM * nN; w += gridDim.x) { int pm, pn; tile_map(w, nM, nN, pm, pn);
      gemm_tile<PW, PW, PW>(yb, w_o0, pm * 256, pn * 256, shm, wave_s,
        [&](int col) { Pre r; r.a = *(const f32x4*)(gm + col); r.b = *(const f32x4*)(gm + col + 4); return r; },
        [&](int row, int col) { Pre r; const size_t ix = (size_t)row * DM + col; r.a = *(const f32x4*)(x + ix); r.b = *(const f32x4*)(x + ix + 4); return r; },
        [&](EPI_ARGS) {
        const size_t ix = (size_t)row * DM + col; const f32x4 x0 = pv.a + lo, x1 = pv.b + hi;
        *(f32x4*)(out + ix) = x0; *(f32x4*)(out + ix + 4) = x1;
        *(bf16x8*)(h1 + ix) = pack8(x0 * cp.a, x1 * cp.b);
        const float sq = half_sum(dot8(x0, x1));
        if ((col & 255) == 0) ss1[(size_t)row * 4 + (col >> 8)] = sq; }); } }
  }
  if constexpr (FUSED) { KParams P_ = kp; asm volatile("" : "+s"(P_)); xcd_barrier((unsigned*)(P_->ws + WS_BAR), xb_st, wave_s); }
  if constexpr ((MASK >> 6) & 1) { PHASE_PTRS
  { constexpr int nM = T / 256, nN = 3; const float* gq = p.mla_q_norm; const float* gkv = p.mla_kv_norm;
    for (int w = blockIdx.x; w < nM * nN; w += gridDim.x) { int pm, pn; tile_map(w, nM, nN, pm, pn);
      gemm_tile<DM, DM, DM>(h1, w_in1, pm * 256, pn * 256, shm, wave_s,
        [&](int col) { Pre r{}; if (col < QL) { r.a = *(const f32x4*)(gq + col); r.b = *(const f32x4*)(gq + col + 4); } else if (col < LATW) { r.a = *(const f32x4*)(gkv + col - QL); r.b = *(const f32x4*)(gkv + col - QL + 4); } return r; },
        [&](int row, int col) { Pre r; r.a = *(const f32x4*)(ss1 + (size_t)row * 4); r.b = f32x4{}; return r; },
        [&](EPI_ARGS) {
        const f32x4 s4 = pv.a; const float inv1 = rsqrtf((s4[0] + s4[1] + s4[2] + s4[3]) * (1.f / DM) + EPS);
        lo *= inv1; hi *= inv1;
        float sq = 0.f, sk = 0.f;
        if (col < QL) { sq = dot8(lo, hi);
          *(bf16x8*)(qn + (size_t)row * QL + col) = pack8(lo * cp.a, hi * cp.b); }
        else if (col < LATW) { sk = dot8(lo, hi); const int c = col - QL;
          *(bf16x8*)(kvn + (size_t)row * KVL + c) = pack8(lo * cp.a, hi * cp.b); }
        else if (col < LATW + DR) { const int i0 = col - LATW, fi = i0 & 31;
          const float* pp = ctp + (i0 < 32 ? 32 : -32); const f32x4 pl = *(const f32x4*)pp * inv1, ph = *(const f32x4*)(pp + 4) * inv1;
          const float* cp = cs + (size_t)row * 32 + fi; const float* sp = sn + (size_t)row * 32 + fi;
          const f32x4 c0 = *(const f32x4*)cp, c1 = *(const f32x4*)(cp + 4), s0 = *(const f32x4*)sp, s1 = *(const f32x4*)(sp + 4);
          f32x4 o0, o1; if (i0 < 32) { o0 = lo * c0 - pl * s0; o1 = hi * c1 - ph * s1; } else { o0 = lo * c0 + pl * s0; o1 = hi * c1 + ph * s1; }
          *(bf16x8*)(kr + (size_t)row * DR + i0) = pack8(o0, o1); }
        sq = half_sum(sq); sk = half_sum(sk);
        if ((col & 255) == 0) { const int pn_ = col >> 8; if (pn_ < 2) ssq[(size_t)row * 2 + pn_] = sq; if (pn_ >= 1) ssk[(size_t)row * 2 + pn_ - 1] = sk; } }); } }
  }
  if constexpr (FUSED) { KParams P_ = kp; asm volatile("" : "+s"(P_)); xcd_barrier((unsigned*)(P_->ws + WS_BAR), xb_st, wave_s); }
  for (int b = FUSED ? 0 : b_arg; b < (FUSED ? NB : b_arg + 1); ++b) {
  constexpr bool P8_BOTH = ((MASK >> 8) & 1) && ((MASK >> 13) & 1);
  for (int pass = 0; pass < (P8_BOTH ? 2 : 1); ++pass) {
  const bool swapped = P8_BOTH && ((blockIdx.x >> 3) & 1);
  const bool run_q = !P8_BOTH || ((pass == 0) != swapped), run_kv = !P8_BOTH || ((pass == 1) != swapped);
  if constexpr ((MASK >> 8) & 1) { if (run_q) { PHASE_PTRS
    { constexpr int nMb = S / 256, nq = nMb * 12;
      const bf16* qa = qn + (size_t)b * S * QL;
      for (int w = blockIdx.x; w < nq; w += gridDim.x) {
        { int pm, pn; tile_map(w, nMb, 12, pm, pn);
          gemm_tile<QL, QL, QL>(qa, w_q, pm * 256, pn * 256, shm, wave_s, NOCPRE,
            [&](int row, int col) { Pre r{}; const float* sp = ssq + ((size_t)b * S + row) * 2; r.a[0] = sp[0]; r.a[1] = sp[1]; return r; },
            [&](EPI_ARGS) {
            const float inv = rsqrtf((pv.a[0] + pv.a[1]) * (1.f / QL) + EPS) * (SM_SCALE * 1.4426950408889634f);
            const int hh = col / DQK, d = col - hh * DQK;
            *(bf16x8*)(Qb + ((size_t)hh * S + row) * DQK + d) = pack8(lo * inv, hi * inv); }); }
      } }
  } }
    if constexpr ((MASK >> 13) & 1) { if (run_kv) { PHASE_PTRS
    { constexpr int nMb = S / 256, nkv = nMb * 16; const bf16* ka = kvn + (size_t)b * S * KVL;
      for (int w = blockIdx.x; w < nkv; w += gridDim.x) {
        { int pm, pn; tile_map(w, nMb, 16, pm, pn);
          gemm_tile<KVL, KVL, KVL>(ka, w_kv, pm * 256, pn * 256, shm, wave_s, NOCPRE,
            [&](int row, int col) { Pre r{}; const float* sp = ssk + ((size_t)b * S + row) * 2; r.a[0] = sp[0]; r.a[1] = sp[1]; return r; },
            [&](EPI_ARGS) {
            const float inv = rsqrtf((pv.a[0] + pv.a[1]) * (1.f / KVL) + EPS);
            const int hh = col >> 8, wi = col & 255;
            bf16* d;
            if (wi < 128) d = Kb + wi + ((size_t)hh * S + row) * 128;
            else { const int c = wi - 128, k = row & 63;
              d = Vb + ((size_t)hh * S + (row - k)) * 128 + (v_st(k, c) >> 1); }
            *(bf16x8*)d = pack8(lo * inv, hi * inv); }); } } }
  } }
  }
    if constexpr (FUSED) { KParams P_ = kp; asm volatile("" : "+s"(P_)); xcd_barrier((unsigned*)(P_->ws + WS_BAR), xb_st, wave_s); }
  if constexpr ((MASK >> 9) & 1) { PHASE_PTRS
    attn_phase(b, Qb, Kb, Vb, kr, ob, cs, sn, lds, wave_s);
  }
    if constexpr (FUSED) { KParams P_ = kp; asm volatile("" : "+s"(P_)); xcd_barrier((unsigned*)(P_->ws + WS_BAR), xb_st, wave_s); }
  }
  if constexpr ((MASK >> 10) & 1) { PHASE_PTRS
  { constexpr int nM = T / 256, nN = PW / 256;
    for (int w = blockIdx.x; w < nM * nN; w += gridDim.x) { int pm, pn; tile_map(w, nM, nN, pm, pn);
      gemm_tile<DM, DM, DM>(h1, w_in1 + (size_t)(LATW + DR) * DM, pm * 256, pn * 256, shm, wave_s, NOCPRE,
        [&](int row, int col) { Pre r; r.a = *(const f32x4*)(ob + (size_t)row * PW + col); r.b = *(const f32x4*)(ss1 + (size_t)row * 4); return r; },
        [&](EPI_ARGS) {
        const f32x4 s4 = pv.b; const float inv1 = rsqrtf((s4[0] + s4[1] + s4[2] + s4[3]) * (1.f / DM) + EPS);
        lo *= inv1; hi *= inv1;
        bf16* d = ob + (size_t)row * PW + col; const bf16x8 ov = *reinterpret_cast<const bf16x8*>(&pv.a);
        UNR for (int e = 0; e < 4; ++e) { lo[e] = silu_f(lo[e]) * bf2f((unsigned short)ov[e]); hi[e] = silu_f(hi[e]) * bf2f((unsigned short)ov[4 + e]); }
        *(bf16x8*)d = pack8(lo, hi); }); } }
  }
  if constexpr (FUSED) { KParams P_ = kp; asm volatile("" : "+s"(P_)); xcd_barrier((unsigned*)(P_->ws + WS_BAR), xb_st, wave_s); }
  bool fused_tail = false;
  if constexpr (FUSED) { fused_tail = gridDim.x >= 256;
    if (fused_tail) { PHASE_PTRS
      constexpr int nM = T / 256, nN = DM / 256; int pm = 0, pn = 0; const bool active = blockIdx.x < nM * nN;
      if (active) tile_map(blockIdx.x, nM, nN, pm, pn);
      final_tile(active, ob, w_o1, pm * 256, pn * 256, shm, wave_s, p.out, ss1, p.final_norm,
                 [&]() { KParams P_ = kp; asm volatile("" : "+s"(P_)); xcd_barrier((unsigned*)(P_->ws + WS_BAR), xb_st, wave_s); }); } }
  if (!fused_tail) {
  if constexpr ((MASK >> 11) & 1) { PHASE_PTRS
  { constexpr int nM = T / 256, nN = DM / 256; float* out = p.out;
    for (int w = blockIdx.x; w < nM * nN; w += gridDim.x) { int pm, pn; tile_map(w, nM, nN, pm, pn);
      gemm_tile<PW, PW, PW>(ob, w_o1, pm * 256, pn * 256, shm, wave_s, NOCPRE,
        [&](int row, int col) { Pre r; const float* d = out + (size_t)row * DM + col; r.a = *(const f32x4*)d; r.b = *(const f32x4*)(d + 4); return r; },
        [&](EPI_ARGS) {
        float* d = out + (size_t)row * DM + col; *(f32x4*)d = pv.a + lo; *(f32x4*)(d + 4) = pv.b + hi; }); } }
  }
  if constexpr (FUSED) { KParams P_ = kp; asm volatile("" : "+s"(P_)); xcd_barrier((unsigned*)(P_->ws + WS_BAR), xb_st, wave_s); }
  if constexpr ((MASK >> 12) & 1) { PHASE_PTRS
  rmsnorm_rows_f32_inplace(p.out, p.final_norm, wave_s);
  }
  }
}

constexpr int LDS_BYTES = LDS_MAIN + 16;

template <int MASK>
static bool launch_phase(const Params& p, int b, int grid, hipStream_t stream) {
  static bool attr_done = false;
  if (!attr_done) { attr_done = true;
    if (hipFuncSetAttribute((const void*)fwd_kernel<MASK>, hipFuncAttributeMaxDynamicSharedMemorySize, LDS_BYTES) != hipSuccess) { fprintf(stderr, "kernel_launch: hipFuncSetAttribute failed (mask %x)\n", MASK); return false; } }
  fwd_kernel<MASK><<<dim3(grid), dim3(512), LDS_BYTES, stream>>>(p, b);
  return true;
}

extern "C" void kernel_launch(void* const* d_in, const int* in_sizes, int n_in, void* d_out, int out_size, void* d_ws, size_t ws_size, hipStream_t stream) {
  static int grid_blocks = 0;
  if (grid_blocks == 0) {
    if (n_in != 15 || in_sizes[0] != T * DM || out_size != T * DM || ws_size < WS_END) {
      fprintf(stderr, "kernel_launch: shape/workspace mismatch (n_in %d, in0 %d, out %d, ws %zu, need %zu)\n", n_in, n_in > 0 ? in_sizes[0] : -1, out_size, ws_size, (size_t)WS_END);
      grid_blocks = -1; return; }
    int dev = 0, cus = 0, per_cu = 0;
    (void)hipGetDevice(&dev);
    (void)hipDeviceGetAttribute(&cus, hipDeviceAttributeMultiprocessorCount, dev);
#if N_LAUNCH_MODE == 0
    if (hipFuncSetAttribute((const void*)fwd_kernel<0x3fff>, hipFuncAttributeMaxDynamicSharedMemorySize, LDS_BYTES) != hipSuccess) { fprintf(stderr, "kernel_launch: hipFuncSetAttribute failed\n"); grid_blocks = -1; return; }
    if (hipOccupancyMaxActiveBlocksPerMultiprocessor(&per_cu, (const void*)fwd_kernel<0x3fff>, 512, LDS_BYTES) != hipSuccess || per_cu < 1) { fprintf(stderr, "kernel_launch: occupancy query failed (%d)\n", per_cu); grid_blocks = -1; return; }
#endif
    (void)per_cu;
    grid_blocks = cus;
  }
  if (grid_blocks < 0) return;
  Params p{};
  p.x = (const float*)d_in[0]; p.pos = (const int*)d_in[1];
  p.pool_norm = (const float*)d_in[2]; p.pool_w_in = (const float*)d_in[3]; p.pool_w_group = (const float*)d_in[4]; p.pool_scale = (const float*)d_in[5]; p.pool_w_out = (const float*)d_in[6];
  p.mla_norm = (const float*)d_in[7]; p.mla_w_in = (const float*)d_in[8]; p.mla_q_norm = (const float*)d_in[9]; p.mla_w_q_b = (const float*)d_in[10]; p.mla_kv_norm = (const float*)d_in[11];
  p.mla_w_kv_b = (const float*)d_in[12]; p.mla_w_out = (const float*)d_in[13]; p.final_norm = (const float*)d_in[14];
  p.out = (float*)d_out; p.ws = (unsigned char*)d_ws;
#if N_LAUNCH_MODE == 0
  if (hipMemsetAsync((char*)d_ws + WS_BAR, 0, XCD_BAR_WORDS * 4, stream) != hipSuccess) { fprintf(stderr, "kernel_launch: memset of the barrier word failed\n"); return; }
  int b0 = 0;
  void* args[] = {&p, &b0};
  hipError_t e = hipLaunchCooperativeKernel((const void*)fwd_kernel<0x3fff>, dim3(grid_blocks), dim3(512), args, LDS_BYTES, stream);
  if (e != hipSuccess) fprintf(stderr, "cooperative launch failed: %s (grid %d)\n", hipGetErrorString(e), grid_blocks);
#else
  const int g = grid_blocks;
  launch_phase<1 << 0>(p, 0, g, stream); launch_phase<1 << 1>(p, 0, g, stream); launch_phase<1 << 2>(p, 0, g, stream); launch_phase<1 << 3>(p, 0, g, stream);
  launch_phase<1 << 4>(p, 0, g, stream); launch_phase<1 << 6>(p, 0, g, stream);
  for (int b = 0; b < NB; ++b) { launch_phase<1 << 8>(p, b, g, stream); launch_phase<1 << 13>(p, b, g, stream); launch_phase<1 << 9>(p, b, g, stream); }
  launch_phase<1 << 10>(p, 0, g, stream); launch_phase<1 << 11>(p, 0, g, stream); launch_phase<1 << 12>(p, 0, g, stream);
#endif
}
```

```cpp
#include <hip/hip_runtime.h>
#include <hip/hip_bf16.h>
#include <hip/hip_cooperative_groups.h>
#include <cstdio>
#include <cstdint>
namespace cg = cooperative_groups;
#ifndef N_LAUNCH_MODE
#define N_LAUNCH_MODE 0
#endif

using bf16 = __hip_bfloat16;
typedef short bf16x8 __attribute__((ext_vector_type(8)));
typedef short s16x4 __attribute__((ext_vector_type(4)));
typedef float f32x16 __attribute__((ext_vector_type(16)));
typedef float f32x4 __attribute__((ext_vector_type(4)));
typedef unsigned u32x4 __attribute__((ext_vector_type(4)));
typedef unsigned u32x2 __attribute__((ext_vector_type(2)));

constexpr int NB = 2, S = 8192, T = NB * S, DM = 1024, PW = 2048, NH = 16;
constexpr int QL = 384, KVL = 256, DR = 64, DN = 128, DQK = 192, DV = 128;
constexpr int MLA_IN = QL + KVL + DR + PW;
constexpr int LATW = QL + KVL;
constexpr float EPS = 1e-6f;

constexpr size_t MiB = 1u << 20;
constexpr size_t WS_WIN1 = 0;
constexpr size_t WS_WQ   = 5 * MiB + MiB / 2;
constexpr size_t WS_WKV  = 7 * MiB + 3 * MiB / 4;
constexpr size_t WS_WO1  = 9 * MiB + 3 * MiB / 4;
constexpr size_t WS_COS  = 14 * MiB;
constexpr size_t WS_SIN  = 16 * MiB;
constexpr size_t WS_WIN0 = 18 * MiB;
constexpr size_t WS_WG   = 26 * MiB;
constexpr size_t WS_WO0  = 28 * MiB;
constexpr size_t WS_H0   = 32 * MiB;
constexpr size_t WS_U    = 64 * MiB;
constexpr size_t WS_SZ   = 128 * MiB;
constexpr size_t WS_PL   = 192 * MiB;
constexpr size_t WS_H1   = 18 * MiB;
constexpr size_t WS_QN   = 50 * MiB;
constexpr size_t WS_KVN  = 62 * MiB;
constexpr size_t WS_KR   = 70 * MiB;
constexpr size_t WS_O    = 72 * MiB;
constexpr size_t WS_QB   = 136 * MiB;
constexpr size_t WS_KB   = 184 * MiB;
constexpr size_t WS_VB   = 216 * MiB;
constexpr size_t WS_SS1  = 248 * MiB;
constexpr size_t WS_SSQ  = 248 * MiB + MiB / 2;
constexpr size_t WS_SSK  = 249 * MiB;
constexpr size_t WS_BAR  = 13 * MiB + 7 * MiB / 8;
constexpr size_t WS_END  = 256 * MiB;

struct Params {
  const float* x; const int* pos;
  const float* pool_norm; const float* pool_w_in; const float* pool_w_group; const float* pool_scale; const float* pool_w_out;
  const float* mla_norm; const float* mla_w_in; const float* mla_q_norm; const float* mla_w_q_b; const float* mla_kv_norm;
  const float* mla_w_kv_b; const float* mla_w_out; const float* final_norm;
  float* out; unsigned char* ws;
};

__device__ __forceinline__ unsigned cvtpk(float lo, float hi) {
  unsigned r; asm volatile("v_cvt_pk_bf16_f32 %0, %1, %2" : "=v"(r) : "v"(lo), "v"(hi)); return r;
}
__device__ __forceinline__ unsigned short f2bf(float v) { return (unsigned short)(cvtpk(v, v) & 0xffffu); }
__device__ __forceinline__ float bf2f(unsigned short h) { return __uint_as_float(((unsigned)h) << 16); }
__device__ __forceinline__ bf16x8 pack8(f32x4 a, f32x4 b) {
  u32x4 w = {cvtpk(a[0], a[1]), cvtpk(a[2], a[3]), cvtpk(b[0], b[1]), cvtpk(b[2], b[3])};
  return *reinterpret_cast<bf16x8*>(&w);
}
__device__ __forceinline__ float silu_f(float z) { return z * __builtin_amdgcn_rcpf(1.f + __builtin_amdgcn_exp2f(-1.4426950408889634f * z)); }
__device__ __forceinline__ int phase_tid(int wave_s) {
  int lane; asm volatile("v_mbcnt_lo_u32_b32 %0, -1, 0\n\tv_mbcnt_hi_u32_b32 %0, -1, %0" : "=v"(lane));
  return wave_s * 64 + lane;
}
#define DPP_F(v, ctrl) __int_as_float(__builtin_amdgcn_update_dpp(0, __float_as_int(v), ctrl, 0xF, 0xF, true))
__device__ __forceinline__ float half_sum(float v) {
  v += DPP_F(v, 0xB1); v += DPP_F(v, 0x4E); v += DPP_F(v, 0x141); v += DPP_F(v, 0x140);
  v += __int_as_float(__builtin_amdgcn_ds_swizzle(__float_as_int(v), 0x401F));
  return v;
}
__device__ __forceinline__ float dot8(f32x4 a, f32x4 b) { return a[0]*a[0] + a[1]*a[1] + a[2]*a[2] + a[3]*a[3] + b[0]*b[0] + b[1]*b[1] + b[2]*b[2] + b[3]*b[3]; }
__device__ __forceinline__ float wave_sum(float v) {
  v += DPP_F(v, 0xB1);
  v += DPP_F(v, 0x4E);
  v += DPP_F(v, 0x141);
  v += DPP_F(v, 0x140);
  v += __int_as_float(__builtin_amdgcn_ds_swizzle(__float_as_int(v), 0x401F));
  auto rr = __builtin_amdgcn_permlane32_swap(__float_as_uint(v), __float_as_uint(v), false, false);
  return __uint_as_float(rr[0]) + __uint_as_float(rr[1]);
}

constexpr int BM = 256, BK = 64, HALF = 128, NXCD = 8, WGM = 8, HT = HALF * BK;
constexpr int CT_LD = 260;
constexpr int GEMM_LDS = 128 * CT_LD * 4;
typedef f32x4 acc_t[2][2][4][2];

__device__ __forceinline__ int lds_byte(int r, int c) {
  int st = (r >> 4) * 2 + (c >> 5), rr = r & 15, cc = c & 31, ob = rr * 64 + cc * 2;
  return st * 1024 + (ob ^ (((ob >> 9) & 1) << 5));
}
__device__ __forceinline__ void stage_rc(int b, int& R, int& C) {
  int st = b / 1024, sb = b % 1024, swz = sb ^ (((sb >> 9) & 1) << 5);
  R = (st >> 1) * 16 + swz / 64; C = (st & 1) * 32 + (swz % 64) / 2;
}

struct Pre { f32x4 a, b; };
template <int K, int LDA, int LDB, bool SWAP = false>
__device__ __forceinline__ void gemm_main(const bf16* __restrict__ A, const bf16* __restrict__ Bt, int brow, int bcol, bf16* shm, int wave_s, acc_t& acc) {
#define SA(b, h) (shm + ((b) * 2 + (h)) * HT)
#define SB(b, h) (shm + (4 + (b) * 2 + (h)) * HT)
#define STAGE(P, BASE, LD, br, kt, OFF) do { const bf16* _gb = (BASE) + ((long)(br) * (LD) + (long)(kt) * BK); \
    __builtin_amdgcn_global_load_lds((const unsigned*)(_gb + OFF##0), (__attribute__((address_space(3))) unsigned*)((char*)(P) + tid * 16), 16, 0, 0); \
    __builtin_amdgcn_global_load_lds((const unsigned*)(_gb + OFF##1), (__attribute__((address_space(3))) unsigned*)((char*)(P) + tid * 16 + 8192), 16, 0, 0); } while (0)
#define STA(P, br, kt) STAGE(P, A, LDA, br, kt, offA)
#define STB(P, br, kt) STAGE(P, Bt, LDB, br, kt, offB)
#define LDA_(dst, b, h) for (int m = 0; m < 4; ++m) for (int k = 0; k < 2; ++k) \
    dst[m][k] = *reinterpret_cast<const bf16x8*>((char*)SA(b, h) + lds_byte(wr * 64 + m * 16 + fr, k * 32 + fq * 8))
#define LDB_(dst, b, h) for (int n = 0; n < 2; ++n) for (int k = 0; k < 2; ++k) \
    dst[n][k] = *reinterpret_cast<const bf16x8*>((char*)SB(b, h) + lds_byte(wc * 32 + n * 16 + fr, k * 32 + fq * 8))
#define MMA(ai, bj, At_, Bt_) do { __builtin_amdgcn_s_setprio(1); \
    for (int m = 0; m < 4; ++m) for (int n = 0; n < 2; ++n) for (int k = 0; k < 2; ++k) \
      acc[ai][bj][m][n] = SWAP ? __builtin_amdgcn_mfma_f32_16x16x32_bf16(Bt_[n][k], At_[m][k], acc[ai][bj][m][n], 0, 0, 0) \
                               : __builtin_amdgcn_mfma_f32_16x16x32_bf16(At_[m][k], Bt_[n][k], acc[ai][bj][m][n], 0, 0, 0); \
    __builtin_amdgcn_s_setprio(0); } while (0)
#define WAIT_V(n) asm volatile("s_waitcnt vmcnt(" #n ")" ::: "memory")
#define WAIT_L(n) asm volatile("s_waitcnt lgkmcnt(" #n ")" ::: "memory")
#define BAR __builtin_amdgcn_s_barrier()
#define SCHED __builtin_amdgcn_sched_barrier(0)
  static_assert(K % 128 == 0 && K >= 256, "K");
  const int tid = phase_tid(wave_s);
  const int wid = tid >> 6, lane = tid & 63, wr = wid >> 2, wc = wid & 3, fr = lane & 15, fq = lane >> 4;
  unsigned offA0, offA1, offB0, offB1;
  { int _r, _c; stage_rc(tid * 16, _r, _c); offA0 = _r * LDA + _c; offB0 = _r * LDB + _c;
    stage_rc(tid * 16 + 8192, _r, _c); offA1 = _r * LDA + _c; offB1 = _r * LDB + _c; }
#pragma unroll
  for (int a_ = 0; a_ < 2; ++a_) for (int b_ = 0; b_ < 2; ++b_) for (int m_ = 0; m_ < 4; ++m_) for (int n_ = 0; n_ < 2; ++n_) acc[a_][b_][m_][n_] = f32x4{};
  bf16x8 At[4][2], B0[2][2], B1[2][2];
  int nt = K / BK; asm volatile("" : "+s"(nt));
  STB(SB(0, 0), bcol, 0); STA(SA(0, 0), brow, 0);
  STB(SB(0, 1), bcol + HALF, 0); STA(SA(0, 1), brow + HALF, 0);
  if (wr == 1) BAR;
  WAIT_V(4); BAR;
  STB(SB(1, 0), bcol, 1); STA(SA(1, 0), brow, 1); STB(SB(1, 1), bcol + HALF, 1);
  WAIT_V(6); BAR;
#pragma nounroll
  for (int t = 0; t < nt - 2; t += 2) {
    LDB_(B0, 0, 0); SCHED; LDA_(At, 0, 0); STA(SA(1, 1), brow + HALF, t + 1);
    WAIT_L(8); BAR; WAIT_L(0); MMA(0, 0, At, B0); BAR; SCHED;
    LDB_(B1, 0, 1); STB(SB(0, 0), bcol, t + 2);
    BAR; WAIT_L(0); MMA(0, 1, At, B1); BAR;
    LDA_(At, 0, 1); STA(SA(0, 0), brow, t + 2);
    BAR; WAIT_L(0); MMA(1, 0, At, B0); BAR; SCHED;
    STB(SB(0, 1), bcol + HALF, t + 2);
    WAIT_V(6); BAR; MMA(1, 1, At, B1); BAR;
    LDB_(B0, 1, 0); SCHED; LDA_(At, 1, 0); STA(SA(0, 1), brow + HALF, t + 2);
    WAIT_L(8); BAR; WAIT_L(0); MMA(0, 0, At, B0); BAR; SCHED;
    LDB_(B1, 1, 1); STB(SB(1, 0), bcol, t + 3);
    BAR; WAIT_L(0); MMA(0, 1, At, B1); BAR;
    LDA_(At, 1, 1); STA(SA(1, 0), brow, t + 3);
    BAR; WAIT_L(0); MMA(1, 0, At, B0); BAR; SCHED;
    STB(SB(1, 1), bcol + HALF, t + 3);
    WAIT_V(6); BAR; MMA(1, 1, At, B1); BAR;
  }
  { LDB_(B0, 0, 0); LDA_(At, 0, 0); STA(SA(1, 1), brow + HALF, nt - 1);
    BAR; WAIT_L(0); MMA(0, 0, At, B0); BAR;
    LDB_(B1, 0, 1); BAR; WAIT_L(0); MMA(0, 1, At, B1); BAR;
    LDA_(At, 0, 1); WAIT_V(4); BAR; WAIT_L(0); MMA(1, 0, At, B0); MMA(1, 1, At, B1); BAR; }
  { LDB_(B0, 1, 0); LDA_(At, 1, 0); WAIT_V(2); BAR; WAIT_L(0); MMA(0, 0, At, B0); BAR;
    LDB_(B1, 1, 1); WAIT_V(0); BAR; WAIT_L(0); MMA(0, 1, At, B1); BAR;
    LDA_(At, 1, 1); BAR; WAIT_L(0); MMA(1, 0, At, B0); MMA(1, 1, At, B1); BAR; }
  if (wr == 0) BAR;
#undef SA
#undef SB
#undef STAGE
#undef STA
#undef STB
#undef LDA_
#undef LDB_
#undef MMA
#undef WAIT_V
#undef WAIT_L
#undef BAR
#undef SCHED
}
#define CT_DUMP(ai) do { \
    _Pragma("unroll") for (int bj = 0; bj < 2; ++bj) _Pragma("unroll") for (int m = 0; m < 4; ++m) _Pragma("unroll") for (int n = 0; n < 2; ++n) \
      *(f32x4*)(ct + ctw + (m * 16) * CT_LD + bj * 128 + n * 16) = acc[ai][bj][m][n]; } while (0)
template <int K, int LDA, int LDB, class CPreF, class PreF, class Epi>
__device__ __forceinline__ void gemm_tile(const bf16* __restrict__ A, const bf16* __restrict__ Bt, int brow, int bcol, bf16* shm, int wave_s, CPreF cpre, PreF pre, Epi epi) {
  acc_t acc;
  gemm_main<K, LDA, LDB, true>(A, Bt, brow, bcol, shm, wave_s, acc);
  float* ct = (float*)shm;
  const int tid2 = phase_tid(wave_s);
  const int ctw = (((tid2 >> 8) & 1) * 64 + (tid2 & 15)) * CT_LD + ((tid2 >> 6) & 3) * 32 + ((tid2 >> 4) & 3) * 4;
  const int ecc = (tid2 & 31) * 8, erow = tid2 >> 5;
  const Pre cpv = cpre(bcol + ecc);
#define CT_PRE(PV, ai) do { _Pragma("unroll") for (int it = 0; it < 8; ++it) PV[it] = pre(brow + (ai) * 128 + it * 16 + erow, bcol + ecc); } while (0)
#define CT_FIN(PV, ai) do { _Pragma("unroll") for (int it = 0; it < 8; ++it) { const int row = it * 16 + erow; const float* cp_ = ct + row * CT_LD + ecc; \
      const f32x4 lo = *(const f32x4*)cp_, hi = *(const f32x4*)(cp_ + 4); \
      epi(brow + (ai) * 128 + row, bcol + ecc, lo, hi, cp_, cpv, PV[it]); } } while (0)
  Pre pvA[8], pvB[8];
  CT_PRE(pvA, 0);
  CT_DUMP(0);
  __syncthreads();
  CT_PRE(pvB, 1);
  CT_FIN(pvA, 0);
  __syncthreads();
  CT_DUMP(1);
  __syncthreads();
  CT_FIN(pvB, 1);
  __syncthreads();
#undef CT_PRE
#undef CT_FIN
}
template <class BarF>
__device__ __forceinline__ void final_tile(bool active, const bf16* __restrict__ A, const bf16* __restrict__ Bt, int brow, int bcol, bf16* shm, int wave_s,
                                           float* out, float* ss2, const float* __restrict__ gfin, BarF grid_bar) {
  f32x4 xl[2][8], xh[2][8];
  const int tid2 = phase_tid(wave_s);
  const int ctw = (((tid2 >> 8) & 1) * 64 + (tid2 & 15)) * CT_LD + ((tid2 >> 6) & 3) * 32 + ((tid2 >> 4) & 3) * 4;
  const int ecc = (tid2 & 31) * 8, erow = tid2 >> 5;
  if (active) {
    acc_t acc;
    gemm_main<PW, PW, PW, true>(A, Bt, brow, bcol, shm, wave_s, acc);
    float* ct = (float*)shm;
#pragma unroll
    for (int ai = 0; ai < 2; ++ai) {
      f32x4 pa[8], pb[8];
#pragma unroll
      for (int it = 0; it < 8; ++it) { const float* d = out + (size_t)(brow + ai * 128 + it * 16 + erow) * DM + bcol + ecc; pa[it] = *(const f32x4*)d; pb[it] = *(const f32x4*)(d + 4); }
      CT_DUMP(ai);
      __syncthreads();
#pragma unroll
      for (int it = 0; it < 8; ++it) { const int row = it * 16 + erow; const float* cp_ = ct + row * CT_LD + ecc;
        xl[ai][it] = pa[it] + *(const f32x4*)cp_; xh[ai][it] = pb[it] + *(const f32x4*)(cp_ + 4);
        const float sq = half_sum(dot8(xl[ai][it], xh[ai][it]));
        if (ecc == 0) ss2[(size_t)(brow + ai * 128 + row) * 4 + (bcol >> 8)] = sq; }
      __syncthreads();
    }
  }
  grid_bar();
  if (active) {
    const f32x4 g0 = *(const f32x4*)(gfin + bcol + ecc), g1 = *(const f32x4*)(gfin + bcol + ecc + 4);
#pragma unroll
    for (int ai = 0; ai < 2; ++ai) {
      float inv[8];
#pragma unroll
      for (int it = 0; it < 8; ++it) { const f32x4 s4 = *(const f32x4*)(ss2 + (size_t)(brow + ai * 128 + it * 16 + erow) * 4); inv[it] = rsqrtf((s4[0] + s4[1] + s4[2] + s4[3]) * (1.f / DM) + EPS); }
#pragma unroll
      for (int it = 0; it < 8; ++it) { float* d = out + (size_t)(brow + ai * 128 + it * 16 + erow) * DM + bcol + ecc;
        *(f32x4*)d = xl[ai][it] * inv[it] * g0; *(f32x4*)(d + 4) = xh[ai][it] * inv[it] * g1; }
    }
  }
}
#define UNR _Pragma("unroll")
#define NOPRE [&](int, int) { return Pre{}; }
#define NOCPRE [&](int) { return Pre{}; }
#define EPI_ARGS int row, int col, f32x4 lo, f32x4 hi, const float* ctp, const Pre& cp, const Pre& pv
__device__ __forceinline__ void tile_map(int w, int nM, int nN, int& pm, int& pn) {
  const int nwg = nM * nN;
  int q = nwg / NXCD, r = nwg % NXCD, xcd = w % NXCD, off = w / NXCD;
  int wgid = (xcd < r ? xcd * (q + 1) : r * (q + 1) + (xcd - r) * q) + off;
  int nig = WGM * nN, gid = wgid / nig, fm = gid * WGM, gsz = min(nM - fm, WGM);
  pm = fm + ((wgid % nig) % gsz); pn = (wgid % nig) / gsz;
}

constexpr float SM_SCALE = 0.07216878364870322f;
constexpr float THR = 8.f;
constexpr int NW = 8, QBLK = 32, KVBLK = 64, QB = NW * QBLK;
constexpr int SHM_V = KVBLK * DV * 2, SHM_K = KVBLK * DQK * 2;
constexpr int ATT_LDS = 2 * SHM_V + 2 * SHM_K + NW * 64 * 4;
constexpr int LDS_MAIN = GEMM_LDS > ATT_LDS ? GEMM_LDS : ATT_LDS;
constexpr int KROW = DQK * 2;
#define KSWZ(row, colB) ((row) * KROW + ((colB) ^ (((row) & 7) << 4)))
#define SBAR() __builtin_amdgcn_sched_barrier(0)
__device__ __forceinline__ int v_st(int k, int c) { const int kk = (k & ~0xC) | ((k & 4) << 1) | ((k & 8) >> 1); return ((kk >> 3) * 4 + (c >> 5)) * 512 + ((kk & 7) * 32 + (c & 31)) * 2; }
__device__ __forceinline__ int v_rd_base(int lane) { return ((lane & 3) << 3) | (((lane >> 2) & 3) << 6) | (((lane >> 4) & 1) << 5) | (((lane >> 5) & 1) << 8); }
constexpr int v_rd_off(int d0, int ks, int half) { return d0 * 512 + ks * 4096 + half * 2048; }
__device__ __forceinline__ int crow(int r, int hi) { return (r & 3) + 8 * (r >> 2) + 4 * hi; }

__device__ __forceinline__ void mask_tile(f32x16& p0, f32x16& p1, int dq) {
  const float NEG = -__builtin_inff();
#pragma unroll
  for (int r = 0; r < 16; ++r) {
    const int c = (r & 3) + 8 * (r >> 2);
    if (dq - c < 0) p0[r] = NEG;
    if (dq - c - 32 < 0) p1[r] = NEG;
  }
}
constexpr float THR2 = THR * 1.4426950408889634f;
__device__ __forceinline__ void partialSM(f32x16& p0, f32x16& p1, float& m_reg, float& alpha, bool first, f32x16& msp) {
  float pmax = p0[0];
#pragma unroll
  for (int r = 1; r < 16; ++r) pmax = fmaxf(pmax, p0[r]);
#pragma unroll
  for (int r = 0; r < 16; ++r) pmax = fmaxf(pmax, p1[r]);
  { auto rr = __builtin_amdgcn_permlane32_swap(__float_as_uint(pmax), __float_as_uint(pmax), false, false);
    pmax = fmaxf(__uint_as_float(rr[0]), __uint_as_float(rr[1])); }
  if (__builtin_expect(!first && __all(pmax <= THR2), 1)) { alpha = 1.f; }
  else { const float d = first ? pmax : fmaxf(pmax, 0.f); alpha = first ? 0.f : __builtin_amdgcn_exp2f(-d); m_reg += d;
#pragma unroll
    for (int r = 0; r < 16; ++r) { p0[r] -= d; p1[r] -= d; msp[r] = -m_reg; } }
#pragma unroll
  for (int r = 0; r < 16; ++r) p0[r] = __builtin_amdgcn_exp2f(p0[r]);
}
__device__ __forceinline__ void finishSM(f32x16& p0, f32x16& p1, float alpha, float& l_reg, bf16x8& pa0, bf16x8& pa1, bf16x8& pa2, bf16x8& pa3) {
#pragma unroll
  for (int r = 0; r < 16; ++r) p1[r] = __builtin_amdgcn_exp2f(p1[r]);
  float ps = 0;
#pragma unroll
  for (int r = 0; r < 16; ++r) ps += p0[r];
#pragma unroll
  for (int r = 0; r < 16; ++r) ps += p1[r];
  { auto rr = __builtin_amdgcn_permlane32_swap(__float_as_uint(ps), __float_as_uint(ps), false, false);
    ps = __uint_as_float(rr[0]) + __uint_as_float(rr[1]); }
  l_reg = l_reg * alpha + ps;
#define PK4(P, B_, OUT) do { unsigned a0 = cvtpk(P[B_+0], P[B_+1]), a1 = cvtpk(P[B_+2], P[B_+3]); \
    unsigned b0 = cvtpk(P[B_+4], P[B_+5]), b1 = cvtpk(P[B_+6], P[B_+7]); \
    auto r0 = __builtin_amdgcn_permlane32_swap(a0, b0, false, false); auto r1 = __builtin_amdgcn_permlane32_swap(a1, b1, false, false); \
    u32x4 w = {r0[0], r1[0], r0[1], r1[1]}; OUT = *reinterpret_cast<bf16x8*>(&w); } while (0)
  PK4(p0, 0, pa0); PK4(p0, 8, pa1); PK4(p1, 0, pa2); PK4(p1, 8, pa3);
#undef PK4
}
template <int KB, class F>
__device__ __forceinline__ void qkt(f32x16& p0, f32x16& p1, const int (&kb)[8], const bf16x8* qr, const f32x16& msp, F issue_dma) {
  constexpr int KOFF = KB * SHM_K;
#define KRD(dst, base, off) asm volatile("ds_read_b128 %0, %1 offset:%2" : "=&v"(dst) : "v"(base), "i"(off) : "memory")
#define KPAIR(d) KRD(ka##d, kb[(d) < 8 ? ((d) & 3) : (d) - 4], KOFF + ((d) < 8 ? ((d) >> 2) * 128 : 0)); KRD(kc##d, kb[(d) < 8 ? ((d) & 3) : (d) - 4], KOFF + ((d) < 8 ? ((d) >> 2) * 128 + 8192 : 4096))
#define KMMA(d) p0 = __builtin_amdgcn_mfma_f32_32x32x16_bf16(ka##d, qr[d], p0, 0, 0, 0); p1 = __builtin_amdgcn_mfma_f32_32x32x16_bf16(kc##d, qr[d], p1, 0, 0, 0)
#define KMMA0() p0 = __builtin_amdgcn_mfma_f32_32x32x16_bf16(ka0, qr[0], msp, 0, 0, 0); p1 = __builtin_amdgcn_mfma_f32_32x32x16_bf16(kc0, qr[0], msp, 0, 0, 0)
#define LW(n) asm volatile("s_waitcnt lgkmcnt(" #n ")" ::: "memory"); SBAR()
  bf16x8 ka0, ka1, ka2, ka3, ka4, ka5, ka6, ka7, ka8, ka9, ka10, ka11, kc0, kc1, kc2, kc3, kc4, kc5, kc6, kc7, kc8, kc9, kc10, kc11;
  KPAIR(0); KPAIR(1); KPAIR(2);
  issue_dma();
  KPAIR(3); LW(6); KMMA0();
  KPAIR(4); LW(6); KMMA(1);
  KPAIR(5); LW(6); KMMA(2);
  KPAIR(6); LW(6); KMMA(3);
  KPAIR(7); LW(6); KMMA(4);
  KPAIR(8); LW(6); KMMA(5);
  KPAIR(9); LW(6); KMMA(6);
  KPAIR(10); LW(6); KMMA(7);
  KPAIR(11); LW(6); KMMA(8);
  LW(4); KMMA(9); LW(2); KMMA(10); LW(0); KMMA(11);
#undef KRD
#undef KPAIR
#undef KMMA
#undef KMMA0
#undef LW
}
template <int VB>
__device__ __forceinline__ void pv_tile(f32x16* o, int vb0, bf16x8 pa0, bf16x8 pa1, bf16x8 pa2, bf16x8 pa3) {
#define TRRD(dst, off) asm volatile("ds_read_b64_tr_b16 %0, %1 offset:%2" : "=&v"(dst) : "v"(vb0), "i"(off) : "memory")
#define VRD8(P, d0) do { constexpr int b_ = VB * SHM_V + v_rd_off(d0, 0, 0); \
    TRRD(P##l0, b_); TRRD(P##h0, b_ + 2048); TRRD(P##l1, b_ + 4096); TRRD(P##h1, b_ + 6144); TRRD(P##l2, b_ + 8192); TRRD(P##h2, b_ + 10240); TRRD(P##l3, b_ + 12288); TRRD(P##h3, b_ + 14336); } while (0)
#define VMMA(P, d0) do { \
    o[d0] = __builtin_amdgcn_mfma_f32_32x32x16_bf16(pa0, (bf16x8){P##l0[0], P##l0[1], P##l0[2], P##l0[3], P##h0[0], P##h0[1], P##h0[2], P##h0[3]}, o[d0], 0, 0, 0); \
    o[d0] = __builtin_amdgcn_mfma_f32_32x32x16_bf16(pa1, (bf16x8){P##l1[0], P##l1[1], P##l1[2], P##l1[3], P##h1[0], P##h1[1], P##h1[2], P##h1[3]}, o[d0], 0, 0, 0); \
    o[d0] = __builtin_amdgcn_mfma_f32_32x32x16_bf16(pa2, (bf16x8){P##l2[0], P##l2[1], P##l2[2], P##l2[3], P##h2[0], P##h2[1], P##h2[2], P##h2[3]}, o[d0], 0, 0, 0); \
    o[d0] = __builtin_amdgcn_mfma_f32_32x32x16_bf16(pa3, (bf16x8){P##l3[0], P##l3[1], P##l3[2], P##l3[3], P##h3[0], P##h3[1], P##h3[2], P##h3[3]}, o[d0], 0, 0, 0); } while (0)
#define LW(n) asm volatile("s_waitcnt lgkmcnt(" #n ")" ::: "memory"); SBAR()
  s16x4 xl0, xl1, xl2, xl3, xh0, xh1, xh2, xh3, yl0, yl1, yl2, yl3, yh0, yh1, yh2, yh3;
  VRD8(x, 0); VRD8(y, 1); LW(8); VMMA(x, 0);
  VRD8(x, 2); LW(8); VMMA(y, 1);
  VRD8(y, 3); LW(8); VMMA(x, 2);
  LW(0); VMMA(y, 3);
#undef TRRD
#undef VRD8
#undef VMMA
#undef LW
}

struct BlockRef { const bf16* Q; const bf16* K; const bf16* KR; const bf16* V; bf16* O; const float* CS; const float* SN; int P0; };

#define LD8(p) (*reinterpret_cast<const bf16x8*>(p))
#define VMW() asm volatile("s_waitcnt vmcnt(0)" ::: "memory")
#define DMA_TILE(k0, bf) do { \
    _Pragma("unroll") for (int p_ = 0; p_ < 2; ++p_) \
      __builtin_amdgcn_global_load_lds((const unsigned*)(cur.K + (size_t)(k0) * DN + koff[p_]), (__attribute__((address_space(3))) unsigned*)(K_lds + (bf) * SHM_K + p_ * 8192 + tid * 16), 16, 0, 0); \
    __builtin_amdgcn_global_load_lds((const unsigned*)(cur.KR + (size_t)(k0) * DR + roff), (__attribute__((address_space(3))) unsigned*)(K_lds + (bf) * SHM_K + 16384 + tid * 16), 16, 0, 0); \
    _Pragma("unroll") for (int p_ = 0; p_ < 2; ++p_) \
      __builtin_amdgcn_global_load_lds((const unsigned*)(cur.V + (size_t)(k0) * DV + vofd[p_]), (__attribute__((address_space(3))) unsigned*)(V_lds + (bf) * SHM_V + p_ * 8192 + tid * 16), 16, 0, 0); } while (0)

__device__ __forceinline__ void attn_block(const BlockRef& cur, char* lds, int wave_s) {
  const int tid = phase_tid(wave_s);
  const int wid = __builtin_amdgcn_readfirstlane(tid >> 6), lane = tid & 63, r32 = lane & 31, hi = lane >> 5;
  unsigned koff[2], vofd[2], roff;
#pragma unroll
  for (int p = 0; p < 2; ++p) { const int b_ = p * 8192 + tid * 16, row = b_ >> 8, pos = (b_ & 255) >> 4;
    const int c = (pos & 8) | ((pos & 7) ^ (row & 7)); koff[p] = row * DN + c * 8; }
  { const int b_ = tid * 16, row = b_ >> 7, pos = (b_ & 127) >> 4; roff = row * DR + (pos ^ (row & 7)) * 8; }
#pragma unroll
  for (int p = 0; p < 2; ++p) { const int b_ = p * 8192 + tid * 16, sub = b_ >> 9, kk = (sub >> 2) * 8 + ((b_ & 511) >> 6), c = (sub & 3) * 32 + ((b_ & 63) >> 1);
    (void)kk; (void)c; vofd[p] = b_ >> 1; }
  char* V_lds = lds; char* K_lds = lds + 2 * SHM_V;
  const int NT = cur.P0 / KVBLK + 4;
  const int qlo = cur.P0 + wid * QBLK, qm = qlo + r32 - 4 * hi;
  float* ws = (float*)(lds + 2 * SHM_V + 2 * SHM_K) + wid * 64; float* li_l = ws, * al_l = ws + 32;
  const int vb0 = (int)(uintptr_t)V_lds + v_rd_base(lane);
  int kb[8];
#pragma unroll
  for (int dd = 0; dd < 4; ++dd) { const int x_ = (dd * 32 + hi * 16) ^ ((r32 & 7) << 4); kb[dd] = (int)(uintptr_t)K_lds + r32 * 256 + x_; kb[4 + dd] = (int)(uintptr_t)K_lds + 16384 + r32 * 128 + x_; }
  bf16x8 qr[12];
#pragma unroll
  for (int d0 = 0; d0 < 12; ++d0) qr[d0] = LD8(cur.Q + (size_t)(wid * QBLK + r32) * DQK + d0 * 16 + hi * 8);
  DMA_TILE(0, 0);
#pragma unroll
  for (int dd = 0; dd < 2; ++dd) {
    const float* cp = cur.CS + (size_t)(wid * QBLK + r32) * 32 + dd * 16 + hi * 8; const float* sp = cur.SN + (size_t)(wid * QBLK + r32) * 32 + dd * 16 + hi * 8;
    const f32x4 c0 = *(const f32x4*)cp, c1 = *(const f32x4*)(cp + 4), s0 = *(const f32x4*)sp, s1 = *(const f32x4*)(sp + 4);
    const bf16x8 qa = qr[8 + dd], qb = qr[10 + dd]; f32x4 na0, na1, nb0, nb1;
#pragma unroll
    for (int j = 0; j < 4; ++j) { const float a0 = bf2f((unsigned short)qa[j]), b0 = bf2f((unsigned short)qb[j]), a1 = bf2f((unsigned short)qa[4 + j]), b1 = bf2f((unsigned short)qb[4 + j]);
      na0[j] = a0 * c0[j] - b0 * s0[j]; nb0[j] = b0 * c0[j] + a0 * s0[j]; na1[j] = a1 * c1[j] - b1 * s1[j]; nb1[j] = b1 * c1[j] + a1 * s1[j]; }
    qr[8 + dd] = pack8(na0, na1); qr[10 + dd] = pack8(nb0, nb1); }
  VMW();
  __syncthreads();
  float m_reg = 0.f, l_reg = 0; f32x16 o[4] = {}; f32x16 msp = {};
#define RESC(a) do { if (__any((a) < 1.f)) { if (hi == 0) al_l[r32] = (a); asm volatile("s_waitcnt lgkmcnt(0)" ::: "memory"); \
    for (int d_ = 0; d_ < 4; ++d_) for (int r = 0; r < 16; ++r) o[d_][r] *= al_l[crow(r, hi)]; } } while (0)
#define STEP(t, KB) do { f32x16 p0, p1; float al; bf16x8 pa0, pa1, pa2, pa3; \
    SBAR(); qkt<KB>(p0, p1, kb, qr, msp, [&]() { if ((t) + 1 < NT) { DMA_TILE(((t) + 1) * KVBLK, 1 - KB); } }); \
    { const int kb_ = (t) * KVBLK; if (kb_ + KVBLK - 1 > qlo) mask_tile(p0, p1, qm - kb_); } \
    partialSM(p0, p1, m_reg, al, (t) == 0, msp); RESC(al); \
    finishSM(p0, p1, al, l_reg, pa0, pa1, pa2, pa3); SBAR(); \
    pv_tile<KB>(o, vb0, pa0, pa1, pa2, pa3); SBAR(); \
    VMW(); __syncthreads(); SBAR(); } while (0)
  for (int t = 0; t < NT; t += 2) { STEP(t, 0); STEP(t + 1, 1); }
  if (hi == 0) li_l[r32] = l_reg; asm volatile("s_waitcnt lgkmcnt(0)" ::: "memory");
  float rli[16];
#pragma unroll
  for (int r = 0; r < 16; ++r) rli[r] = __builtin_amdgcn_rcpf(li_l[crow(r, hi)]);
  bf16* Ow = cur.O + (size_t)(wid * QBLK) * PW;
#pragma unroll
  for (int r = 0; r < 16; ++r) { const int orow = crow(r, hi);
#pragma unroll
    for (int d0 = 0; d0 < 4; ++d0) { const float v = o[d0][r] * rli[r];
      const float vn = DPP_F(v, 0xB1);
      if ((r32 & 1) == 0) *(unsigned*)(Ow + (size_t)orow * PW + d0 * 32 + r32) = cvtpk(v, vn); } }
  __syncthreads();
#undef RESC
#undef STEP
}

__device__ __forceinline__ BlockRef att_ref(int b, int h, int qb, const bf16* Qb, const bf16* Kb, const bf16* Vb, const bf16* kr, bf16* O, const float* cs, const float* sn) {
  BlockRef r;
  r.Q = Qb + ((size_t)h * S + (size_t)qb * QB) * DQK;
  r.K = Kb + (size_t)h * S * DN; r.V = Vb + (size_t)h * S * DV; r.KR = kr + (size_t)b * S * DR;
  r.O = O + ((size_t)b * S + (size_t)qb * QB) * PW + h * DV; r.P0 = qb * QB;
  r.CS = cs + ((size_t)b * S + (size_t)qb * QB) * 32; r.SN = sn + ((size_t)b * S + (size_t)qb * QB) * 32;
  return r;
}
__device__ __forceinline__ void attn_phase(int b, const bf16* Qb, const bf16* Kb, const bf16* Vb, const bf16* kr, bf16* O, const float* cs, const float* sn, char* lds, int wave_s) {
  constexpr int total = NH * 32;
  for (int L = blockIdx.x; L < total; L += gridDim.x) {
    const int pass = L / (NH * 16), Lp = L % (NH * 16);
    const int xcd = Lp & 7, k = Lp >> 3, h = xcd * 2 + (k >> 4), x = k & 15;
    const int qb = pass ? x : 31 - x;
    const BlockRef cur = att_ref(b, h, qb, Qb, Kb, Vb, kr, O, cs, sn);
    attn_block(cur, lds, wave_s);
  }
}

__device__ __forceinline__ void tr_matrix(const float* __restrict__ src, int K, int N, bf16* __restrict__ dst, bool sw, float* tile, int& cursor, int wave_s) {
  (void)sw;
  const int tid = phase_tid(wave_s);
  const int nk = K / 64, nn = N / 64, ntile = nk * nn;
  int i = (blockIdx.x + gridDim.x - (cursor % gridDim.x)) % gridDim.x;
  cursor += ntile;
  const int lr = tid >> 4, lc4 = (tid & 15) * 4;
  f32x4 v0 = {}, v1 = {};
  if (i < ntile) { const float* p = src + (size_t)((i / nn) * 64 + lr) * N + (i % nn) * 64 + lc4; v0 = __builtin_nontemporal_load((const f32x4*)p); v1 = __builtin_nontemporal_load((const f32x4*)(p + (size_t)32 * N)); }
  while (i < ntile) {
    const int k0 = (i / nn) * 64, n0 = (i % nn) * 64;
#pragma unroll
    for (int e = 0; e < 4; ++e) { tile[lr * 65 + lc4 + e] = v0[e]; tile[(lr + 32) * 65 + lc4 + e] = v1[e]; }
    __syncthreads();
    const int inext = i + gridDim.x;
    if (inext < ntile) { const float* p = src + (size_t)((inext / nn) * 64 + lr) * N + (inext % nn) * 64 + lc4; v0 = __builtin_nontemporal_load((const f32x4*)p); v1 = __builtin_nontemporal_load((const f32x4*)(p + (size_t)32 * N)); }
    { const int n = tid >> 3, kk = (tid & 7) * 8;
      f32x4 a, b2;
      a[0] = tile[(kk + 0) * 65 + n]; a[1] = tile[(kk + 1) * 65 + n]; a[2] = tile[(kk + 2) * 65 + n]; a[3] = tile[(kk + 3) * 65 + n];
      b2[0] = tile[(kk + 4) * 65 + n]; b2[1] = tile[(kk + 5) * 65 + n]; b2[2] = tile[(kk + 6) * 65 + n]; b2[3] = tile[(kk + 7) * 65 + n];
      *(bf16x8*)(dst + (size_t)(n0 + n) * K + k0 + kk) = pack8(a, b2); }
    __syncthreads();
    i = inext;
  }
}
template <bool OUT_BF16>
__device__ __forceinline__ void rmsnorm_rows(const float* x, const float* __restrict__ g, bf16* out, float* outf, int wave_s) {
  const int tid_ = phase_tid(wave_s);
  const int wid = tid_ >> 6, lane = tid_ & 63;
  const int stride = gridDim.x * 8;
  int row = blockIdx.x * 8 + wid;
  f32x4 va[4], vb[4], na[4], nb[4];
#define RMS_LOAD(A_, B_, r_) do { const int r2_ = (r_) + stride; const f32x4* xa_ = (const f32x4*)(x + (size_t)(r_) * DM); const f32x4* xb_ = (const f32x4*)(x + (size_t)(r2_ < T ? r2_ : (r_)) * DM); \
    _Pragma("unroll") for (int i = 0; i < 4; ++i) A_[i] = __builtin_nontemporal_load(xa_ + lane + 64 * i); _Pragma("unroll") for (int i = 0; i < 4; ++i) B_[i] = __builtin_nontemporal_load(xb_ + lane + 64 * i); } while (0)
  if (row < T) RMS_LOAD(va, vb, row);
  while (row < T) {
    const int row2 = row + stride, rown = row + 2 * stride; const bool two = row2 < T;
    if (rown < T) RMS_LOAD(na, nb, rown);
    float sa = 0, sb = 0;
#pragma unroll
    for (int i = 0; i < 4; ++i) { sa += va[i][0] * va[i][0] + va[i][1] * va[i][1] + va[i][2] * va[i][2] + va[i][3] * va[i][3];
                                  sb += vb[i][0] * vb[i][0] + vb[i][1] * vb[i][1] + vb[i][2] * vb[i][2] + vb[i][3] * vb[i][3]; }
    sa = wave_sum(sa); sb = wave_sum(sb);
    const float ia = rsqrtf(sa * (1.f / DM) + EPS), ib = rsqrtf(sb * (1.f / DM) + EPS);
#pragma unroll
    for (int i = 0; i < 4; ++i) { const f32x4 gg = ((const f32x4*)g)[lane + 64 * i];
      const f32x4 wa = va[i] * ia * gg, wb = vb[i] * ib * gg;
      if constexpr (OUT_BF16) {
        u32x2 pa = {cvtpk(wa[0], wa[1]), cvtpk(wa[2], wa[3])}; *(u32x2*)(out + (size_t)row * DM + (lane + 64 * i) * 4) = pa;
        if (two) { u32x2 pb = {cvtpk(wb[0], wb[1]), cvtpk(wb[2], wb[3])}; *(u32x2*)(out + (size_t)row2 * DM + (lane + 64 * i) * 4) = pb; } }
      else { ((f32x4*)(outf + (size_t)row * DM))[lane + 64 * i] = wa; if (two) ((f32x4*)(outf + (size_t)row2 * DM))[lane + 64 * i] = wb; } }
#pragma unroll
    for (int i = 0; i < 4; ++i) { va[i] = na[i]; vb[i] = nb[i]; }
    row = rown;
  }
#undef RMS_LOAD
}
__device__ __forceinline__ void rmsnorm_rows_bf16(const float* __restrict__ x, const float* __restrict__ g, bf16* __restrict__ out, int wave_s) { rmsnorm_rows<true>(x, g, out, nullptr, wave_s); }
__device__ __forceinline__ void rmsnorm_rows_f32_inplace(float* x, const float* __restrict__ g, int wave_s) { rmsnorm_rows<false>(x, g, nullptr, x, wave_s); }
__device__ __forceinline__ void rope_tables(const int* __restrict__ pos, float* __restrict__ cs, float* __restrict__ sn, int wave_s) {
  const int tid_ = phase_tid(wave_s);
  for (int idx = blockIdx.x * 512 + tid_; idx < T * 32; idx += gridDim.x * 512) {
    const int t = idx >> 5, i = idx & 31;
    const float inv_freq = 1.0f / powf(10000.0f, (float)(2 * i) / 64.0f);
    const float ang = (float)pos[t] * inv_freq;
    cs[idx] = cosf(ang); sn[idx] = sinf(ang);
  }
}
__device__ __forceinline__ void pool_item(const bf16* __restrict__ u, bf16* __restrict__ pl, int cgx, int t0) {
  {
    const int s0 = t0 & (S - 1);
    const int w = 2 << (cgx >> 6);
    const bf16* up = u + (size_t)t0 * PW + cgx * 8;
    bf16* pp = pl + ((size_t)(cgx >> 6) * T + t0) * 512 + (cgx & 63) * 8;
    float s[8];
#pragma unroll
    for (int e = 0; e < 8; ++e) s[e] = 0.f;
    if (s0 > 0) {
#pragma unroll 4
      for (int d = 1; d <= w; ++d) { const bf16x8 v = LD8(up - (size_t)d * PW);
#pragma unroll
        for (int e = 0; e < 8; ++e) s[e] += bf2f((unsigned short)v[e]); } }
    bf16x8 cv[8], ov[8], cn[8], on[8];
#define POOL_LOAD(C_, O_, i0_) do { \
    _Pragma("unroll") for (int k = 0; k < 8; ++k) C_[k] = LD8(up + (size_t)((i0_) + k) * PW); \
    _Pragma("unroll") for (int k = 0; k < 8; ++k) { const int i = (i0_) + k; O_[k] = LD8(up + (size_t)((s0 + i - w >= 0) ? (i - w) : i) * PW); } } while (0)
    POOL_LOAD(cv, ov, 0);
#pragma unroll
    for (int i0 = 0; i0 < 32; i0 += 8) {
      if (i0 + 8 < 32) POOL_LOAD(cn, on, i0 + 8);
#pragma unroll
      for (int k = 0; k < 8; ++k) { const int i = i0 + k, si = s0 + i; const bool has = si - w >= 0;
        float c[8];
#pragma unroll
        for (int e = 0; e < 8; ++e) { c[e] = bf2f((unsigned short)cv[k][e]); s[e] += c[e]; if (has) s[e] -= bf2f((unsigned short)ov[k][e]); }
        const float rc = 1.f / (float)min(si + 1, w);
        f32x4 a = {s[0] * rc - c[0], s[1] * rc - c[1], s[2] * rc - c[2], s[3] * rc - c[3]};
        f32x4 b2 = {s[4] * rc - c[4], s[5] * rc - c[5], s[6] * rc - c[6], s[7] * rc - c[7]};
        *(bf16x8*)(pp + (size_t)i * 512) = pack8(a, b2); }
#pragma unroll
      for (int k = 0; k < 8; ++k) { cv[k] = cn[k]; ov[k] = on[k]; }
    }
#undef POOL_LOAD
  }
}
__device__ __forceinline__ void pool_phase(const bf16* __restrict__ u, bf16* __restrict__ pl, int wave_s) {
  const int tid_ = phase_tid(wave_s);
  for (int idx = blockIdx.x * 512 + tid_; idx < (T / 32) * 256; idx += gridDim.x * 512) pool_item(u, pl, idx & 255, (idx >> 8) * 32);
}
typedef const __attribute__((address_space(4))) Params* KParams;
#define XB_TMO      128
#define XB_XCNT(j)  (256  + 64 * (j))
#define XB_XSUB(j)  (1280 + 64 * (j))
#define XB_XGEN(j)  (2304 + 64 * (j))
#define XB_TOP      3328
#define XB_TOPGEN   3392
#define XCD_BAR_WORDS 3456
#define XB_SPIN_CAP (1u << 20)
#define LAS __attribute__((address_space(3)))
__device__ __forceinline__ unsigned xb_ld(unsigned* p)              { return __hip_atomic_load(p, __ATOMIC_RELAXED, __HIP_MEMORY_SCOPE_AGENT); }
__device__ __forceinline__ unsigned xb_add(unsigned* p, unsigned v) { return __hip_atomic_fetch_add(p, v, __ATOMIC_RELAXED, __HIP_MEMORY_SCOPE_AGENT); }
__device__ __forceinline__ unsigned xb_xcc_id() { return (unsigned)__builtin_amdgcn_s_getreg((3 << 11) | 20) & 0xFu; }
#define XB_SPIN(cond, bar) do { unsigned _sp = 0; while (cond) { __builtin_amdgcn_s_sleep(1); \
    if ((++_sp & 255u) == 0u) { if (xb_ld(&(bar)[XB_TMO])) break; if (_sp > XB_SPIN_CAP) { atomicAdd(&(bar)[XB_TMO], 1u); break; } } } } while (0)
__device__ __forceinline__ void xcd_barrier_complete(unsigned* bar, unsigned x, unsigned& nloc, unsigned& nx) {
  const unsigned G = gridDim.x;
  unsigned sum, cnt, mine, sp = 0u;
  for (;;) {
    sum = 0u; cnt = 0u; mine = 0u;
#pragma unroll
    for (unsigned j = 0; j < 16; ++j) { const unsigned c = xb_ld(&bar[XB_XCNT(j)]); sum += c; cnt += (c > 0u) ? 1u : 0u; mine = (j == x) ? c : mine; }
    if (sum == G) break;
    __builtin_amdgcn_s_sleep(1);
    if ((++sp & 255u) == 0u) { if (xb_ld(&bar[XB_TMO])) break; if (sp > XB_SPIN_CAP) { atomicAdd(&bar[XB_TMO], 1u); break; } }
  }
  nloc = mine > 0u ? mine : 1u; nx = cnt > 0u ? cnt : 1u;
}
__device__ __forceinline__ void xcd_barrier(unsigned* bar, volatile LAS unsigned* st, int wave_s) {
  asm volatile("s_waitcnt vmcnt(0)" ::: "memory");
  __syncthreads();
  if (phase_tid(wave_s) == 0) {
    const unsigned x = xb_xcc_id();
    __builtin_amdgcn_s_waitcnt(0);
    unsigned nloc = st[0], nx = st[1];
    if (nloc == 0u) { xcd_barrier_complete(bar, x, nloc, nx); st[0] = nloc; st[1] = nx; }
    const unsigned old = xb_add(&bar[XB_XSUB(x)], 1u);
    const unsigned gen = old / nloc;
    if (old + 1u == (gen + 1u) * nloc) {
      __builtin_amdgcn_fence(__ATOMIC_RELEASE, "agent");
      asm volatile("s_waitcnt vmcnt(0)" ::: "memory");
      const unsigned og = xb_add(&bar[XB_TOP], 1u);
      const unsigned tg = og / nx;
      if (og + 1u == (tg + 1u) * nx) xb_add(&bar[XB_TOPGEN], 1u);
      else XB_SPIN(xb_ld(&bar[XB_TOPGEN]) == tg, bar);
      __builtin_amdgcn_fence(__ATOMIC_ACQUIRE, "agent");
      xb_add(&bar[XB_XGEN(x)], 1u);
      asm volatile("s_waitcnt vmcnt(0)" ::: "memory");
    } else {
      XB_SPIN(xb_ld(&bar[XB_XGEN(x)]) == gen, bar);
      __builtin_amdgcn_fence(__ATOMIC_ACQUIRE, "agent");
      asm volatile("s_waitcnt vmcnt(0)" ::: "memory");
    }
  }
  __syncthreads();
}
#define PHASE_PTRS KParams P_ = kp; asm volatile("" : "+s"(P_)); Params p; p.x = P_->x; p.pos = P_->pos; p.pool_norm = P_->pool_norm; p.pool_w_in = P_->pool_w_in; p.pool_w_group = P_->pool_w_group; p.pool_scale = P_->pool_scale; p.pool_w_out = P_->pool_w_out; p.mla_norm = P_->mla_norm; p.mla_w_in = P_->mla_w_in; p.mla_q_norm = P_->mla_q_norm; p.mla_w_q_b = P_->mla_w_q_b; p.mla_kv_norm = P_->mla_kv_norm; p.mla_w_kv_b = P_->mla_w_kv_b; p.mla_w_out = P_->mla_w_out; p.final_norm = P_->final_norm; p.out = P_->out; p.ws = P_->ws; unsigned char* ws = p.ws; \
  bf16* w_in1 = (bf16*)(ws + WS_WIN1); bf16* w_q = (bf16*)(ws + WS_WQ); bf16* w_kv = (bf16*)(ws + WS_WKV); bf16* w_o1 = (bf16*)(ws + WS_WO1); \
  float* cs = (float*)(ws + WS_COS); float* sn = (float*)(ws + WS_SIN); \
  bf16* w_in0 = (bf16*)(ws + WS_WIN0); bf16* w_g = (bf16*)(ws + WS_WG); bf16* w_o0 = (bf16*)(ws + WS_WO0); \
  bf16* h0 = (bf16*)(ws + WS_H0); bf16* u = (bf16*)(ws + WS_U); bf16* yb = (bf16*)(ws + WS_U); bf16* sz = (bf16*)(ws + WS_SZ); bf16* pl = (bf16*)(ws + WS_PL); \
  bf16* h1 = (bf16*)(ws + WS_H1); bf16* qn = (bf16*)(ws + WS_QN); bf16* kvn = (bf16*)(ws + WS_KVN); bf16* kr = (bf16*)(ws + WS_KR); \
  bf16* ob = (bf16*)(ws + WS_O); bf16* Qb = (bf16*)(ws + WS_QB); bf16* Kb = (bf16*)(ws + WS_KB); bf16* Vb = (bf16*)(ws + WS_VB); \
  float* ss1 = (float*)(ws + WS_SS1); float* ssq = (float*)(ws + WS_SSQ); float* ssk = (float*)(ws + WS_SSK);

template <int MASK>
__global__ void __launch_bounds__(512, 2) fwd_kernel(Params p_unused, int b_arg) {
  constexpr bool FUSED = MASK == 0x3fff;
  extern __shared__ __attribute__((aligned(16))) char lds[];
  const int wave_s = __builtin_amdgcn_readfirstlane((int)threadIdx.x >> 6);
  volatile LAS unsigned* xb_st = (volatile LAS unsigned*)(lds + LDS_MAIN);
  KParams kp = (KParams)__builtin_amdgcn_kernarg_segment_ptr();
  if constexpr (FUSED) {
    unsigned* bar0 = (unsigned*)(kp->ws + WS_BAR);
    if (threadIdx.x == 0) { xb_st[0] = 0u; xb_st[1] = 0u;
      (void)xb_add(bar0 + XB_XCNT(xb_xcc_id()), 1u); }
    __syncthreads();
  }
  bf16* shm = (bf16*)lds;
  if constexpr ((MASK >> 0) & 1) { PHASE_PTRS
  { int cur = 0; float* tile = (float*)lds;
    tr_matrix(p.pool_w_in, DM, 2 * PW, w_in0, false, tile, cur, wave_s);
    for (int g = 0; g < 4; ++g) tr_matrix(p.pool_w_group + (size_t)g * 512 * 512, 512, 512, w_g + (size_t)g * 512 * 512, false, tile, cur, wave_s);
    tr_matrix(p.pool_w_out, PW, DM, w_o0, false, tile, cur, wave_s);
    tr_matrix(p.mla_w_in, DM, MLA_IN, w_in1, false, tile, cur, wave_s);
    tr_matrix(p.mla_w_q_b, QL, NH * DQK, w_q, false, tile, cur, wave_s);
    tr_matrix(p.mla_w_kv_b, KVL, NH * (DN + DV), w_kv, false, tile, cur, wave_s);
    tr_matrix(p.mla_w_out, PW, DM, w_o1, false, tile, cur, wave_s);
    rope_tables(p.pos, cs, sn, wave_s);
    rmsnorm_rows_bf16(p.x, p.pool_norm, h0, wave_s); }
  }
  if constexpr (FUSED) { KParams P_ = kp; asm volatile("" : "+s"(P_)); xcd_barrier((unsigned*)(P_->ws + WS_BAR), xb_st, wave_s); }
  if constexpr ((MASK >> 1) & 1) { PHASE_PTRS
  { constexpr int nM = T / 256, nN = (2 * PW) / 256;
    for (int w = blockIdx.x; w < nM * nN; w += gridDim.x) { int pm, pn; tile_map(w, nM, nN, pm, pn);
      gemm_tile<DM, DM, DM>(h0, w_in0, pm * 256, pn * 256, shm, wave_s, NOCPRE, NOPRE, [&](EPI_ARGS) {
        if (col < PW) *(bf16x8*)(u + (size_t)row * PW + col) = pack8(lo, hi);
        else { UNR for (int e = 0; e < 4; ++e) { lo[e] = silu_f(lo[e]); hi[e] = silu_f(hi[e]); }
          *(bf16x8*)(sz + (size_t)row * PW + col - PW) = pack8(lo, hi); } }); } }
  }
  if constexpr (FUSED) { KParams P_ = kp; asm volatile("" : "+s"(P_)); xcd_barrier((unsigned*)(P_->ws + WS_BAR), xb_st, wave_s); }
  if constexpr (!FUSED && ((MASK >> 2) & 1)) { PHASE_PTRS
  pool_phase(u, pl, wave_s);
  }
  if constexpr ((MASK >> 3) & 1) { PHASE_PTRS
  { const float* scale = p.pool_scale;
    constexpr int NU = FUSED ? 256 : 512;
    for (int w = blockIdx.x; w < NU; w += gridDim.x) {
      int g, pm, pn0, pn1;
      if constexpr (FUSED) { g = w >> 6; pm = w & 63; pn0 = 0; pn1 = 2;
        const int tid_ = phase_tid(wave_s);
        pool_item(u, pl, g * 64 + (tid_ & 63), (pm * 8 + (tid_ >> 6)) * 32);
        asm volatile("s_waitcnt vmcnt(0)" ::: "memory");
        __syncthreads(); }
      else { g = w >> 7; const int wi = w & 127; pm = wi >> 1; pn0 = wi & 1; pn1 = pn0 + 1; }
      for (int pn = pn0; pn < pn1; ++pn)
      gemm_tile<512, 512, 512>(pl + (size_t)g * T * 512, w_g + (size_t)g * 512 * 512, pm * 256, pn * 256, shm, wave_s,
        [&](int col) { Pre r; r.a = *(const f32x4*)(scale + g * 512 + col); r.b = *(const f32x4*)(scale + g * 512 + col + 4); return r; },
        [&](int row, int col) { Pre r; r.a = *(const f32x4*)(sz + (size_t)row * PW + g * 512 + col); r.b = f32x4{}; return r; },
        [&](EPI_ARGS) {
        const int c = g * 512 + col; const size_t ix = (size_t)row * PW + c;
        const bf16x8 zz = *reinterpret_cast<const bf16x8*>(&pv.a); const f32x4 s0 = cp.a, s1 = cp.b;
        UNR for (int e = 0; e < 4; ++e) { lo[e] *= s0[e] * bf2f((unsigned short)zz[e]); hi[e] *= s1[e] * bf2f((unsigned short)zz[4 + e]); }
        *(bf16x8*)(yb + ix) = pack8(lo, hi); }); } }
  }
  if constexpr (FUSED) { KParams P_ = kp; asm volatile("" : "+s"(P_)); xcd_barrier((unsigned*)(P_->ws + WS_BAR), xb_st, wave_s); }
  if constexpr ((MASK >> 4) & 1) { PHASE_PTRS
  { constexpr int nM = T / 256, nN = DM / 256; const float* x = p.x; float* out = p.out; const float* gm = p.mla_norm;
    for (int w = blockIdx.x; w < nM * nN; w += gridDim.x) { int pm, pn; tile_map(w, nM, nN, pm, pn);
      gemm_tile<PW, PW, PW>(yb, w_o0, pm * 256, pn * 256, shm, wave_s,
        [&](int col) { Pre r; r.a = *(const f32x4*)(gm + col); r.b = *(const f32x4*)(gm + col + 4); return r; },
        [&](int row, int col) { Pre r; const size_t ix = (size_t)row * DM + col; r.a = *(const f32x4*)(x + ix); r.b = *(const f32x4*)(x + ix + 4); return r; },
        [&](EPI_ARGS) {
        const size_t ix = (size_t)row * DM + col; const f32x4 x0 = pv.a + lo, x1 = pv.b + hi;
        *(f32x4*)(out + ix) = x0; *(f32x4*)(out + ix + 4) = x1;
        *(bf16x8*)(h1 + ix) = pack8(x0 * cp.a, x1 * cp.b);
        const float sq = half_sum(dot8(x0, x1));
        if ((col & 255) == 0) ss1[(size_t)row * 4 + (col >> 8)] = sq; }); } }
  }
  if constexpr (FUSED) { KParams P_ = kp; asm volatile("" : "+s"(P_)); xcd_barrier((unsigned*)(P_->ws + WS_BAR), xb_st, wave_s); }
  if constexpr ((MASK >> 6) & 1) { PHASE_PTRS
  { constexpr int nM = T / 256, nN = 3; const float* gq = p.mla_q_norm; const float* gkv = p.mla_kv_norm;
    for (int w = blockIdx.x; w < nM * nN; w += gridDim.x) { int pm, pn; tile_map(w, nM, nN, pm, pn);
      gemm_tile<DM, DM, DM>(h1, w_in1, pm * 256, pn * 256, shm, wave_s,
        [&](int col) { Pre r{}; if (col < QL) { r.a = *(const f32x4*)(gq + col); r.b = *(const f32x4*)(gq + col + 4); } else if (col < LATW) { r.a = *(const f32x4*)(gkv + col - QL); r.b = *(const f32x4*)(gkv + col - QL + 4); } return r; },
        [&](int row, int col) { Pre r; r.a = *(const f32x4*)(ss1 + (size_t)row * 4); r.b = f32x4{}; return r; },
        [&](EPI_ARGS) {
        const f32x4 s4 = pv.a; const float inv1 = rsqrtf((s4[0] + s4[1] + s4[2] + s4[3]) * (1.f / DM) + EPS);
        lo *= inv1; hi *= inv1;
        float sq = 0.f, sk = 0.f;
        if (col < QL) { sq = dot8(lo, hi);
          *(bf16x8*)(qn + (size_t)row * QL + col) = pack8(lo * cp.a, hi * cp.b); }
        else if (col < LATW) { sk = dot8(lo, hi); const int c = col - QL;
          *(bf16x8*)(kvn + (size_t)row * KVL + c) = pack8(lo * cp.a, hi * cp.b); }
        else if (col < LATW + DR) { const int i0 = col - LATW, fi = i0 & 31;
          const float* pp = ctp + (i0 < 32 ? 32 : -32); const f32x4 pl = *(const f32x4*)pp * inv1, ph = *(const f32x4*)(pp + 4) * inv1;
          const float* cp = cs + (size_t)row * 32 + fi; const float* sp = sn + (size_t)row * 32 + fi;
          const f32x4 c0 = *(const f32x4*)cp, c1 = *(const f32x4*)(cp + 4), s0 = *(const f32x4*)sp, s1 = *(const f32x4*)(sp + 4);
          f32x4 o0, o1; if (i0 < 32) { o0 = lo * c0 - pl * s0; o1 = hi * c1 - ph * s1; } else { o0 = lo * c0 + pl * s0; o1 = hi * c1 + ph * s1; }
          *(bf16x8*)(kr + (size_t)row * DR + i0) = pack8(o0, o1); }
        sq = half_sum(sq); sk = half_sum(sk);
        if ((col & 255) == 0) { const int pn_ = col >> 8; if (pn_ < 2) ssq[(size_t)row * 2 + pn_] = sq; if (pn_ >= 1) ssk[(size_t)row * 2 + pn_ - 1] = sk; } }); } }
  }
  if constexpr (FUSED) { KParams P_ = kp; asm volatile("" : "+s"(P_)); xcd_barrier((unsigned*)(P_->ws + WS_BAR), xb_st, wave_s); }
  for (int b = FUSED ? 0 : b_arg; b < (FUSED ? NB : b_arg + 1); ++b) {
  constexpr bool P8_BOTH = ((MASK >> 8) & 1) && ((MASK >> 13) & 1);
  for (int pass = 0; pass < (P8_BOTH ? 2 : 1); ++pass) {
  const bool swapped = P8_BOTH && ((blockIdx.x >> 3) & 1);
  const bool run_q = !P8_BOTH || ((pass == 0) != swapped), run_kv = !P8_BOTH || ((pass == 1) != swapped);
  if constexpr ((MASK >> 8) & 1) { if (run_q) { PHASE_PTRS
    { constexpr int nMb = S / 256, nq = nMb * 12;
      const bf16* qa = qn + (size_t)b * S * QL;
      for (int w = blockIdx.x; w < nq; w += gridDim.x) {
        { int pm, pn; tile_map(w, nMb, 12, pm, pn);
          gemm_tile<QL, QL, QL>(qa, w_q, pm * 256, pn * 256, shm, wave_s, NOCPRE,
            [&](int row, int col) { Pre r{}; const float* sp = ssq + ((size_t)b * S + row) * 2; r.a[0] = sp[0]; r.a[1] = sp[1]; return r; },
            [&](EPI_ARGS) {
            const float inv = rsqrtf((pv.a[0] + pv.a[1]) * (1.f / QL) + EPS) * (SM_SCALE * 1.4426950408889634f);
            const int hh = col / DQK, d = col - hh * DQK;
            *(bf16x8*)(Qb + ((size_t)hh * S + row) * DQK + d) = pack8(lo * inv, hi * inv); }); }
      } }
  } }
    if constexpr ((MASK >> 13) & 1) { if (run_kv) { PHASE_PTRS
    { constexpr int nMb = S / 256, nkv = nMb * 16; const bf16* ka = kvn + (size_t)b * S * KVL;
      for (int w = blockIdx.x; w < nkv; w += gridDim.x) {
        { int pm, pn; tile_map(w, nMb, 16, pm, pn);
          gemm_tile<KVL, KVL, KVL>(ka, w_kv, pm * 256, pn * 256, shm, wave_s, NOCPRE,
            [&](int row, int col) { Pre r{}; const float* sp = ssk + ((size_t)b * S + row) * 2; r.a[0] = sp[0]; r.a[1] = sp[1]; return r; },
            [&](EPI_ARGS) {
            const float inv = rsqrtf((pv.a[0] + pv.a[1]) * (1.f / KVL) + EPS);
            const int hh = col >> 8, wi = col & 255;
            bf16* d;
            if (wi < 128) d = Kb + wi + ((size_t)hh * S + row) * 128;
            else { const int c = wi - 128, k = row & 63;
              d = Vb + ((size_t)hh * S + (row - k)) * 128 + (v_st(k, c) >> 1); }
            *(bf16x8*)d = pack8(lo * inv, hi * inv); }); } } }
  } }
  }
    if constexpr (FUSED) { KParams P_ = kp; asm volatile("" : "+s"(P_)); xcd_barrier((unsigned*)(P_->ws + WS_BAR), xb_st, wave_s); }
  if constexpr ((MASK >> 9) & 1) { PHASE_PTRS
    attn_phase(b, Qb, Kb, Vb, kr, ob, cs, sn, lds, wave_s);
  }
    if constexpr (FUSED) { KParams P_ = kp; asm volatile("" : "+s"(P_)); xcd_barrier((unsigned*)(P_->ws + WS_BAR), xb_st, wave_s); }
  }
  if constexpr ((MASK >> 10) & 1) { PHASE_PTRS
  { constexpr int nM = T / 256, nN = PW / 256;
    for (int w = blockIdx.x; w < nM * nN; w += gridDim.x) { int pm, pn; tile_map(w, nM, nN, pm, pn);
      gemm_tile<DM, DM, DM>(h1, w_in1 + (size_t)(LATW + DR) * DM, pm * 256, pn * 256, shm, wave_s, NOCPRE,
        [&](int row, int col) { Pre r; r.a = *(const f32x4*)(ob + (size_t)row * PW + col); r.b = *(const f32x4*)(ss1 + (size_t)row * 4); return r; },
        [&](EPI_ARGS) {
        const f32x4 s4 = pv.b; const float inv1 = rsqrtf((s4[0] + s4[1] + s4[2] + s4[3]) * (1.f / DM) + EPS);
        lo *= inv1; hi *= inv1;
        bf16* d = ob + (size_t)row * PW + col; const bf16x8 ov = *reinterpret_cast<const bf16x8*>(&pv.a);
        UNR for (int e = 0; e < 4; ++e) { lo[e] = silu_f(lo[e]) * bf2f((unsigned short)ov[e]); hi[e] = silu_f(hi[e]) * bf2f((unsigned short)ov[4 + e]); }
        *(bf16x8*)d = pack8(lo, hi); }); } }
  }
  if constexpr (FUSED) { KParams P_ = kp; asm volatile("" : "+s"(P_)); xcd_barrier((unsigned*)(P_->ws + WS_BAR), xb_st, wave_s); }
  bool fused_tail = false;
  if constexpr (FUSED) { fused_tail = gridDim.x >= 256;
    if (fused_tail) { PHASE_PTRS
      constexpr int nM = T / 256, nN = DM / 256; int pm = 0, pn = 0; const bool active = blockIdx.x < nM * nN;
      if (active) tile_map(blockIdx.x, nM, nN, pm, pn);
      final_tile(active, ob, w_o1, pm * 256, pn * 256, shm, wave_s, p.out, ss1, p.final_norm,
                 [&]() { KParams P_ = kp; asm volatile("" : "+s"(P_)); xcd_barrier((unsigned*)(P_->ws + WS_BAR), xb_st, wave_s); }); } }
  if (!fused_tail) {
  if constexpr ((MASK >> 11) & 1) { PHASE_PTRS
  { constexpr int nM = T / 256, nN = DM / 256; float* out = p.out;
    for (int w = blockIdx.x; w < nM * nN; w += gridDim.x) { int pm, pn; tile_map(w, nM, nN, pm, pn);
      gemm_tile<PW, PW, PW>(ob, w_o1, pm * 256, pn * 256, shm, wave_s, NOCPRE,
        [&](int row, int col) { Pre r; const float* d = out + (size_t)row * DM + col; r.a = *(const f32x4*)d; r.b = *(const f32x4*)(d + 4); return r; },
        [&](EPI_ARGS) {
        float* d = out + (size_t)row * DM + col; *(f32x4*)d = pv.a + lo; *(f32x4*)(d + 4) = pv.b + hi; }); } }
  }
  if constexpr (FUSED) { KParams P_ = kp; asm volatile("" : "+s"(P_)); xcd_barrier((unsigned*)(P_->ws + WS_BAR), xb_st, wave_s); }
  if constexpr ((MASK >> 12) & 1) { PHASE_PTRS
  rmsnorm_rows_f32_inplace(p.out, p.final_norm, wave_s);
  }
  }
}

constexpr int LDS_BYTES = LDS_MAIN + 16;

template <int MASK>
static bool launch_phase(const Params& p, int b, int grid, hipStream_t stream) {
  static bool attr_done = false;
  if (!attr_done) { attr_done = true;
    if (hipFuncSetAttribute((const void*)fwd_kernel<MASK>, hipFuncAttributeMaxDynamicSharedMemorySize, LDS_BYTES) != hipSuccess) { fprintf(stderr, "kernel_launch: hipFuncSetAttribute failed (mask %x)\n", MASK); return false; } }
  fwd_kernel<MASK><<<dim3(grid), dim3(512), LDS_BYTES, stream>>>(p, b);
  return true;
}

extern "C" void kernel_launch(void* const* d_in, const int* in_sizes, int n_in, void* d_out, int out_size, void* d_ws, size_t ws_size, hipStream_t stream) {
  static int grid_blocks = 0;
  if (grid_blocks == 0) {
    if (n_in != 15 || in_sizes[0] != T * DM || out_size != T * DM || ws_size < WS_END) {
      fprintf(stderr, "kernel_launch: shape/workspace mismatch (n_in %d, in0 %d, out %d, ws %zu, need %zu)\n", n_in, n_in > 0 ? in_sizes[0] : -1, out_size, ws_size, (size_t)WS_END);
      grid_blocks = -1; return; }
    int dev = 0, cus = 0, per_cu = 0;
    (void)hipGetDevice(&dev);
    (void)hipDeviceGetAttribute(&cus, hipDeviceAttributeMultiprocessorCount, dev);
#if N_LAUNCH_MODE == 0
    if (hipFuncSetAttribute((const void*)fwd_kernel<0x3fff>, hipFuncAttributeMaxDynamicSharedMemorySize, LDS_BYTES) != hipSuccess) { fprintf(stderr, "kernel_launch: hipFuncSetAttribute failed\n"); grid_blocks = -1; return; }
    if (hipOccupancyMaxActiveBlocksPerMultiprocessor(&per_cu, (const void*)fwd_kernel<0x3fff>, 512, LDS_BYTES) != hipSuccess || per_cu < 1) { fprintf(stderr, "kernel_launch: occupancy query failed (%d)\n", per_cu); grid_blocks = -1; return; }
#endif
    (void)per_cu;
    grid_blocks = cus;
  }
  if (grid_blocks < 0) return;
  Params p{};
  p.x = (const float*)d_in[0]; p.pos = (const int*)d_in[1];
  p.pool_norm = (const float*)d_in[2]; p.pool_w_in = (const float*)d_in[3]; p.pool_w_group = (const float*)d_in[4]; p.pool_scale = (const float*)d_in[5]; p.pool_w_out = (const float*)d_in[6];
  p.mla_norm = (const float*)d_in[7]; p.mla_w_in = (const float*)d_in[8]; p.mla_q_norm = (const float*)d_in[9]; p.mla_w_q_b = (const float*)d_in[10]; p.mla_kv_norm = (const float*)d_in[11];
  p.mla_w_kv_b = (const float*)d_in[12]; p.mla_w_out = (const float*)d_in[13]; p.final_norm = (const float*)d_in[14];
  p.out = (float*)d_out; p.ws = (unsigned char*)d_ws;
#if N_LAUNCH_MODE == 0
  if (hipMemsetAsync((char*)d_ws + WS_BAR, 0, XCD_BAR_WORDS * 4, stream) != hipSuccess) { fprintf(stderr, "kernel_launch: memset of the barrier word failed\n"); return; }
  int b0 = 0;
  void* args[] = {&p, &b0};
  hipError_t e = hipLaunchCooperativeKernel((const void*)fwd_kernel<0x3fff>, dim3(grid_blocks), dim3(512), args, LDS_BYTES, stream);
  if (e != hipSuccess) fprintf(stderr, "cooperative launch failed: %s (grid %d)\n", hipGetErrorString(e), grid_blocks);
#else
  const int g = grid_blocks;
  launch_phase<1 << 0>(p, 0, g, stream); launch_phase<1 << 1>(p, 0, g, stream); launch_phase<1 << 2>(p, 0, g, stream); launch_phase<1 << 3>(p, 0, g, stream);
  launch_phase<1 << 4>(p, 0, g, stream); launch_phase<1 << 6>(p, 0, g, stream);
  for (int b = 0; b < NB; ++b) { launch_phase<1 << 8>(p, b, g, stream); launch_phase<1 << 13>(p, b, g, stream); launch_phase<1 << 9>(p, b, g, stream); }
  launch_phase<1 << 10>(p, 0, g, stream); launch_phase<1 << 11>(p, 0, g, stream); launch_phase<1 << 12>(p, 0, g, stream);
#endif
}
```

```cpp
#include <hip/hip_runtime.h>
#include <hip/hip_bf16.h>
#include <hip/hip_cooperative_groups.h>
#include <cstdio>
#include <cstdint>
namespace cg = cooperative_groups;
#ifndef N_LAUNCH_MODE
#define N_LAUNCH_MODE 0
#endif

using bf16 = __hip_bfloat16;
typedef short bf16x8 __attribute__((ext_vector_type(8)));
typedef short s16x4 __attribute__((ext_vector_type(4)));
typedef float f32x16 __attribute__((ext_vector_type(16)));
typedef float f32x4 __attribute__((ext_vector_type(4)));
typedef unsigned u32x4 __attribute__((ext_vector_type(4)));
typedef unsigned u32x2 __attribute__((ext_vector_type(2)));

constexpr int NB = 2, S = 8192, T = NB * S, DM = 1024, PW = 2048, NH = 16;
constexpr int QL = 384, KVL = 256, DR = 64, DN = 128, DQK = 192, DV = 128;
constexpr int MLA_IN = QL + KVL + DR + PW;
constexpr int LATW = QL + KVL;
constexpr float EPS = 1e-6f;

constexpr size_t MiB = 1u << 20;
constexpr size_t WS_WIN1 = 0;
constexpr size_t WS_WQ   = 5 * MiB + MiB / 2;
constexpr size_t WS_WKV  = 7 * MiB + 3 * MiB / 4;
constexpr size_t WS_WO1  = 9 * MiB + 3 * MiB / 4;
constexpr size_t WS_COS  = 14 * MiB;
constexpr size_t WS_SIN  = 16 * MiB;
constexpr size_t WS_WIN0 = 18 * MiB;
constexpr size_t WS_WG   = 26 * MiB;
constexpr size_t WS_WO0  = 28 * MiB;
constexpr size_t WS_H0   = 32 * MiB;
constexpr size_t WS_U    = 64 * MiB;
constexpr size_t WS_SZ   = 128 * MiB;
constexpr size_t WS_PL   = 192 * MiB;
constexpr size_t WS_H1   = 18 * MiB;
constexpr size_t WS_QN   = 50 * MiB;
constexpr size_t WS_KVN  = 62 * MiB;
constexpr size_t WS_KR   = 70 * MiB;
constexpr size_t WS_O    = 72 * MiB;
constexpr size_t WS_QB   = 136 * MiB;
constexpr size_t WS_KB   = 184 * MiB;
constexpr size_t WS_VB   = 216 * MiB;
constexpr size_t WS_SS1  = 248 * MiB;
constexpr size_t WS_SSQ  = 248 * MiB + MiB / 2;
constexpr size_t WS_SSK  = 249 * MiB;
constexpr size_t WS_BAR  = 13 * MiB + 7 * MiB / 8;
constexpr size_t WS_END  = 256 * MiB;

struct Params {
  const float* x; const int* pos;
  const float* pool_norm; const float* pool_w_in; const float* pool_w_group; const float* pool_scale; const float* pool_w_out;
  const float* mla_norm; const float* mla_w_in; const float* mla_q_norm; const float* mla_w_q_b; const float* mla_kv_norm;
  const float* mla_w_kv_b; const float* mla_w_out; const float* final_norm;
  float* out; unsigned char* ws;
};

__device__ __forceinline__ unsigned cvtpk(float lo, float hi) {
  unsigned r; asm volatile("v_cvt_pk_bf16_f32 %0, %1, %2" : "=v"(r) : "v"(lo), "v"(hi)); return r;
}
__device__ __forceinline__ unsigned short f2bf(float v) { return (unsigned short)(cvtpk(v, v) & 0xffffu); }
__device__ __forceinline__ float bf2f(unsigned short h) { return __uint_as_float(((unsigned)h) << 16); }
__device__ __forceinline__ bf16x8 pack8(f32x4 a, f32x4 b) {
  u32x4 w = {cvtpk(a[0], a[1]), cvtpk(a[2], a[3]), cvtpk(b[0], b[1]), cvtpk(b[2], b[3])};
  return *reinterpret_cast<bf16x8*>(&w);
}
__device__ __forceinline__ float silu_f(float z) { return z * __builtin_amdgcn_rcpf(1.f + __builtin_amdgcn_exp2f(-1.4426950408889634f * z)); }
__device__ __forceinline__ int phase_tid(int wave_s) {
  int lane; asm volatile("v_mbcnt_lo_u32_b32 %0, -1, 0\n\tv_mbcnt_hi_u32_b32 %0, -1, %0" : "=v"(lane));
  return wave_s * 64 + lane;
}
#define DPP_F(v, ctrl) __int_as_float(__builtin_amdgcn_update_dpp(0, __float_as_int(v), ctrl, 0xF, 0xF, true))
__device__ __forceinline__ float half_sum(float v) {
  v += DPP_F(v, 0xB1); v += DPP_F(v, 0x4E); v += DPP_F(v, 0x141); v += DPP_F(v, 0x140);
  v += __int_as_float(__builtin_amdgcn_ds_swizzle(__float_as_int(v), 0x401F));
  return v;
}
__device__ __forceinline__ float dot8(f32x4 a, f32x4 b) { return a[0]*a[0] + a[1]*a[1] + a[2]*a[2] + a[3]*a[3] + b[0]*b[0] + b[1]*b[1] + b[2]*b[2] + b[3]*b[3]; }
__device__ __forceinline__ float wave_sum(float v) {
  v += DPP_F(v, 0xB1);
  v += DPP_F(v, 0x4E);
  v += DPP_F(v, 0x141);
  v += DPP_F(v, 0x140);
  v += __int_as_float(__builtin_amdgcn_ds_swizzle(__float_as_int(v), 0x401F));
  auto rr = __builtin_amdgcn_permlane32_swap(__float_as_uint(v), __float_as_uint(v), false, false);
  return __uint_as_float(rr[0]) + __uint_as_float(rr[1]);
}

constexpr int BM = 256, BK = 64, HALF = 128, NXCD = 8, WGM = 8, HT = HALF * BK;
constexpr int CT_LD = 260;
constexpr int GEMM_LDS = 128 * CT_LD * 4;
typedef f32x4 acc_t[2][2][4][2];

__device__ __forceinline__ int lds_byte(int r, int c) {
  int st = (r >> 4) * 2 + (c >> 5), rr = r & 15, cc = c & 31, ob = rr * 64 + cc * 2;
  return st * 1024 + (ob ^ (((ob >> 9) & 1) << 5));
}
__device__ __forceinline__ void stage_rc(int b, int& R, int& C) {
  int st = b / 1024, sb = b % 1024, swz = sb ^ (((sb >> 9) & 1) << 5);
  R = (st >> 1) * 16 + swz / 64; C = (st & 1) * 32 + (swz % 64) / 2;
}

struct Pre { f32x4 a, b; };
template <int K, int LDA, int LDB, bool SWAP = false>
__device__ __forceinline__ void gemm_main(const bf16* __restrict__ A, const bf16* __restrict__ Bt, int brow, int bcol, bf16* shm, int wave_s, acc_t& acc) {
#define SA(b, h) (shm + ((b) * 2 + (h)) * HT)
#define SB(b, h) (shm + (4 + (b) * 2 + (h)) * HT)
#define STAGE(P, BASE, LD, br, kt, OFF) do { const bf16* _gb = (BASE) + ((long)(br) * (LD) + (long)(kt) * BK); \
    __builtin_amdgcn_global_load_lds((const unsigned*)(_gb + OFF##0), (__attribute__((address_space(3))) unsigned*)((char*)(P) + tid * 16), 16, 0, 0); \
    __builtin_amdgcn_global_load_lds((const unsigned*)(_gb + OFF##1), (__attribute__((address_space(3))) unsigned*)((char*)(P) + tid * 16 + 8192), 16, 0, 0); } while (0)
#define STA(P, br, kt) STAGE(P, A, LDA, br, kt, offA)
#define STB(P, br, kt) STAGE(P, Bt, LDB, br, kt, offB)
#define LDA_(dst, b, h) for (int m = 0; m < 4; ++m) for (int k = 0; k < 2; ++k) \
    dst[m][k] = *reinterpret_cast<const bf16x8*>((char*)SA(b, h) + lds_byte(wr * 64 + m * 16 + fr, k * 32 + fq * 8))
#define LDB_(dst, b, h) for (int n = 0; n < 2; ++n) for (int k = 0; k < 2; ++k) \
    dst[n][k] = *reinterpret_cast<const bf16x8*>((char*)SB(b, h) + lds_byte(wc * 32 + n * 16 + fr, k * 32 + fq * 8))
#define MMA(ai, bj, At_, Bt_) do { __builtin_amdgcn_s_setprio(1); \
    for (int m = 0; m < 4; ++m) for (int n = 0; n < 2; ++n) for (int k = 0; k < 2; ++k) \
      acc[ai][bj][m][n] = SWAP ? __builtin_amdgcn_mfma_f32_16x16x32_bf16(Bt_[n][k], At_[m][k], acc[ai][bj][m][n], 0, 0, 0) \
                               : __builtin_amdgcn_mfma_f32_16x16x32_bf16(At_[m][k], Bt_[n][k], acc[ai][bj][m][n], 0, 0, 0); \
    __builtin_amdgcn_s_setprio(0); } while (0)
#define WAIT_V(n) asm volatile("s_waitcnt vmcnt(" #n ")" ::: "memory")
#define WAIT_L(n) asm volatile("s_waitcnt lgkmcnt(" #n ")" ::: "memory")
#define BAR __builtin_amdgcn_s_barrier()
#define SCHED __builtin_amdgcn_sched_barrier(0)
  static_assert(K % 128 == 0 && K >= 256, "K");
  const int tid = phase_tid(wave_s);
  const int wid = tid >> 6, lane = tid & 63, wr = wid >> 2, wc = wid & 3, fr = lane & 15, fq = lane >> 4;
  unsigned offA0, offA1, offB0, offB1;
  { int _r, _c; stage_rc(tid * 16, _r, _c); offA0 = _r * LDA + _c; offB0 = _r * LDB + _c;
    stage_rc(tid * 16 + 8192, _r, _c); offA1 = _r * LDA + _c; offB1 = _r * LDB + _c; }
#pragma unroll
  for (int a_ = 0; a_ < 2; ++a_) for (int b_ = 0; b_ < 2; ++b_) for (int m_ = 0; m_ < 4; ++m_) for (int n_ = 0; n_ < 2; ++n_) acc[a_][b_][m_][n_] = f32x4{};
  bf16x8 At[4][2], B0[2][2], B1[2][2];
  int nt = K / BK; asm volatile("" : "+s"(nt));
  STB(SB(0, 0), bcol, 0); STA(SA(0, 0), brow, 0);
  STB(SB(0, 1), bcol + HALF, 0); STA(SA(0, 1), brow + HALF, 0);
  if (wr == 1) BAR;
  WAIT_V(4); BAR;
  STB(SB(1, 0), bcol, 1); STA(SA(1, 0), brow, 1); STB(SB(1, 1), bcol + HALF, 1);
  WAIT_V(6); BAR;
#pragma nounroll
  for (int t = 0; t < nt - 2; t += 2) {
    LDB_(B0, 0, 0); SCHED; LDA_(At, 0, 0); STA(SA(1, 1), brow + HALF, t + 1);
    WAIT_L(8); BAR; WAIT_L(0); MMA(0, 0, At, B0); BAR; SCHED;
    LDB_(B1, 0, 1); STB(SB(0, 0), bcol, t + 2);
    BAR; WAIT_L(0); MMA(0, 1, At, B1); BAR;
    LDA_(At, 0, 1); STA(SA(0, 0), brow, t + 2);
    BAR; WAIT_L(0); MMA(1, 0, At, B0); BAR; SCHED;
    STB(SB(0, 1), bcol + HALF, t + 2);
    WAIT_V(6); BAR; MMA(1, 1, At, B1); BAR;
    LDB_(B0, 1, 0); SCHED; LDA_(At, 1, 0); STA(SA(0, 1), brow + HALF, t + 2);
    WAIT_L(8); BAR; WAIT_L(0); MMA(0, 0, At, B0); BAR; SCHED;
    LDB_(B1, 1, 1); STB(SB(1, 0), bcol, t + 3);
    BAR; WAIT_L(0); MMA(0, 1, At, B1); BAR;
    LDA_(At, 1, 1); STA(SA(1, 0), brow, t + 3);
    BAR; WAIT_L(0); MMA(1, 0, At, B0); BAR; SCHED;
    STB(SB(1, 1), bcol + HALF, t + 3);
    WAIT_V(6); BAR; MMA(1, 1, At, B1); BAR;
  }
  { LDB_(B0, 0, 0); LDA_(At, 0, 0); STA(SA(1, 1), brow + HALF, nt - 1);
    BAR; WAIT_L(0); MMA(0, 0, At, B0); BAR;
    LDB_(B1, 0, 1); BAR; WAIT_L(0); MMA(0, 1, At, B1); BAR;
    LDA_(At, 0, 1); WAIT_V(4); BAR; WAIT_L(0); MMA(1, 0, At, B0); MMA(1, 1, At, B1); BAR; }
  { LDB_(B0, 1, 0); LDA_(At, 1, 0); WAIT_V(2); BAR; WAIT_L(0); MMA(0, 0, At, B0); BAR;
    LDB_(B1, 1, 1); WAIT_V(0); BAR; WAIT_L(0); MMA(0, 1, At, B1); BAR;
    LDA_(At, 1, 1); BAR; WAIT_L(0); MMA(1, 0, At, B0); MMA(1, 1, At, B1); BAR; }
  if (wr == 0) BAR;
#undef SA
#undef SB
#undef STAGE
#undef STA
#undef STB
#undef LDA_
#undef LDB_
#undef MMA
#undef WAIT_V
#undef WAIT_L
#undef BAR
#undef SCHED
}
#define CT_DUMP(ai) do { \
    _Pragma("unroll") for (int bj = 0; bj < 2; ++bj) _Pragma("unroll") for (int m = 0; m < 4; ++m) _Pragma("unroll") for (int n = 0; n < 2; ++n) \
      *(f32x4*)(ct + ctw + (m * 16) * CT_LD + bj * 128 + n * 16) = acc[ai][bj][m][n]; } while (0)
template <int K, int LDA, int LDB, class CPreF, class PreF, class Epi>
__device__ __forceinline__ void gemm_tile(const bf16* __restrict__ A, const bf16* __restrict__ Bt, int brow, int bcol, bf16* shm, int wave_s, CPreF cpre, PreF pre, Epi epi) {
  acc_t acc;
  gemm_main<K, LDA, LDB, true>(A, Bt, brow, bcol, shm, wave_s, acc);
  float* ct = (float*)shm;
  const int tid2 = phase_tid(wave_s);
  const int ctw = (((tid2 >> 8) & 1) * 64 + (tid2 & 15)) * CT_LD + ((tid2 >> 6) & 3) * 32 + ((tid2 >> 4) & 3) * 4;
  const int ecc = (tid2 & 31) * 8, erow = tid2 >> 5;
  const Pre cpv = cpre(bcol + ecc);
#define CT_PRE(PV, ai) do { _Pragma("unroll") for (int it = 0; it < 8; ++it) PV[it] = pre(brow + (ai) * 128 + it * 16 + erow, bcol + ecc); } while (0)
#define CT_FIN(PV, ai) do { _Pragma("unroll") for (int it = 0; it < 8; ++it) { const int row = it * 16 + erow; const float* cp_ = ct + row * CT_LD + ecc; \
      const f32x4 lo = *(const f32x4*)cp_, hi = *(const f32x4*)(cp_ + 4); \
      epi(brow + (ai) * 128 + row, bcol + ecc, lo, hi, cp_, cpv, PV[it]); } } while (0)
  Pre pvA[8], pvB[8];
  CT_PRE(pvA, 0);
  CT_DUMP(0);
  __syncthreads();
  CT_PRE(pvB, 1);
  CT_FIN(pvA, 0);
  __syncthreads();
  CT_DUMP(1);
  __syncthreads();
  CT_FIN(pvB, 1);
  __syncthreads();
#undef CT_PRE
#undef CT_FIN
}
template <class BarF>
__device__ __forceinline__ void final_tile(bool active, const bf16* __restrict__ A, const bf16* __restrict__ Bt, int brow, int bcol, bf16* shm, int wave_s,
                                           float* out, float* ss2, const float* __restrict__ gfin, BarF grid_bar) {
  f32x4 xl[2][8], xh[2][8];
  const int tid2 = phase_tid(wave_s);
  const int ctw = (((tid2 >> 8) & 1) * 64 + (tid2 & 15)) * CT_LD + ((tid2 >> 6) & 3) * 32 + ((tid2 >> 4) & 3) * 4;
  const int ecc = (tid2 & 31) * 8, erow = tid2 >> 5;
  if (active) {
    acc_t acc;
    gemm_main<PW, PW, PW, true>(A, Bt, brow, bcol, shm, wave_s, acc);
    float* ct = (float*)shm;
#pragma unroll
    for (int ai = 0; ai < 2; ++ai) {
      f32x4 pa[8], pb[8];
#pragma unroll
      for (int it = 0; it < 8; ++it) { const float* d = out + (size_t)(brow + ai * 128 + it * 16 + erow) * DM + bcol + ecc; pa[it] = *(const f32x4*)d; pb[it] = *(const f32x4*)(d + 4); }
      CT_DUMP(ai);
      __syncthreads();
#pragma unroll
      for (int it = 0; it < 8; ++it) { const int row = it * 16 + erow; const float* cp_ = ct + row * CT_LD + ecc;
        xl[ai][it] = pa[it] + *(const f32x4*)cp_; xh[ai][it] = pb[it] + *(const f32x4*)(cp_ + 4);
        const float sq = half_sum(dot8(xl[ai][it], xh[ai][it]));
        if (ecc == 0) ss2[(size_t)(brow + ai * 128 + row) * 4 + (bcol >> 8)] = sq; }
      __syncthreads();
    }
  }
  grid_bar();
  if (active) {
    const f32x4 g0 = *(const f32x4*)(gfin + bcol + ecc), g1 = *(const f32x4*)(gfin + bcol + ecc + 4);
#pragma unroll
    for (int ai = 0; ai < 2; ++ai) {
      float inv[8];
#pragma unroll
      for (int it = 0; it < 8; ++it) { const f32x4 s4 = *(const f32x4*)(ss2 + (size_t)(brow + ai * 128 + it * 16 + erow) * 4); inv[it] = rsqrtf((s4[0] + s4[1] + s4[2] + s4[3]) * (1.f / DM) + EPS); }
#pragma unroll
      for (int it = 0; it < 8; ++it) { float* d = out + (size_t)(brow + ai * 128 + it * 16 + erow) * DM + bcol + ecc;
        *(f32x4*)d = xl[ai][it] * inv[it] * g0; *(f32x4*)(d + 4) = xh[ai][it] * inv[it] * g1; }
    }
  }
}
#define UNR _Pragma("unroll")
#define NOPRE [&](int, int) { return Pre{}; }
#define NOCPRE [&](int) { return Pre{}; }
#define EPI_ARGS int row, int col, f32x4 lo, f32x4 hi, const float* ctp, const Pre& cp, const Pre& pv
__device__ __forceinline__ void tile_map(int w, int nM, int nN, int& pm, int& pn) {
  const int nwg = nM * nN;
  int q = nwg / NXCD, r = nwg % NXCD, xcd = w % NXCD, off = w / NXCD;
  int wgid = (xcd < r ? xcd * (q + 1) : r * (q + 1) + (xcd - r) * q) + off;
  int nig = WGM * nN, gid = wgid / nig, fm = gid * WGM, gsz = min(nM - fm, WGM);
  pm = fm + ((wgid % nig) % gsz); pn = (wgid % nig) / gsz;
}

constexpr float SM_SCALE = 0.07216878364870322f;
constexpr float THR = 8.f;
constexpr int NW = 8, QBLK = 32, KVBLK = 64, QB = NW * QBLK;
constexpr int SHM_V = KVBLK * DV * 2, SHM_K = KVBLK * DQK * 2;
constexpr int ATT_LDS = 2 * SHM_V + 2 * SHM_K + NW * 64 * 4;
constexpr int LDS_MAIN = GEMM_LDS > ATT_LDS ? GEMM_LDS : ATT_LDS;
constexpr int KROW = DQK * 2;
#define KSWZ(row, colB) ((row) * KROW + ((colB) ^ (((row) & 7) << 4)))
#define SBAR() __builtin_amdgcn_sched_barrier(0)
__device__ __forceinline__ int v_st(int k, int c) { const int kk = (k & ~0xC) | ((k & 4) << 1) | ((k & 8) >> 1); return ((kk >> 3) * 4 + (c >> 5)) * 512 + ((kk & 7) * 32 + (c & 31)) * 2; }
__device__ __forceinline__ int v_rd_base(int lane) { return ((lane & 3) << 3) | (((lane >> 2) & 3) << 6) | (((lane >> 4) & 1) << 5) | (((lane >> 5) & 1) << 8); }
constexpr int v_rd_off(int d0, int ks, int half) { return d0 * 512 + ks * 4096 + half * 2048; }
__device__ __forceinline__ int crow(int r, int hi) { return (r & 3) + 8 * (r >> 2) + 4 * hi; }

__device__ __forceinline__ void mask_tile(f32x16& p0, f32x16& p1, int dq) {
  const float NEG = -__builtin_inff();
#pragma unroll
  for (int r = 0; r < 16; ++r) {
    const int c = (r & 3) + 8 * (r >> 2);
    if (dq - c < 0) p0[r] = NEG;
    if (dq - c - 32 < 0) p1[r] = NEG;
  }
}
constexpr float THR2 = THR * 1.4426950408889634f;
__device__ __forceinline__ void partialSM(f32x16& p0, f32x16& p1, float& m_reg, float& alpha, bool first, f32x16& msp) {
  float pmax = p0[0];
#pragma unroll
  for (int r = 1; r < 16; ++r) pmax = fmaxf(pmax, p0[r]);
#pragma unroll
  for (int r = 0; r < 16; ++r) pmax = fmaxf(pmax, p1[r]);
  { auto rr = __builtin_amdgcn_permlane32_swap(__float_as_uint(pmax), __float_as_uint(pmax), false, false);
    pmax = fmaxf(__uint_as_float(rr[0]), __uint_as_float(rr[1])); }
  if (__builtin_expect(!first && __all(pmax <= THR2), 1)) { alpha = 1.f; }
  else { const float d = first ? pmax : fmaxf(pmax, 0.f); alpha = first ? 0.f : __builtin_amdgcn_exp2f(-d); m_reg += d;
#pragma unroll
    for (int r = 0; r < 16; ++r) { p0[r] -= d; p1[r] -= d; msp[r] = -m_reg; } }
#pragma unroll
  for (int r = 0; r < 16; ++r) p0[r] = __builtin_amdgcn_exp2f(p0[r]);
}
__device__ __forceinline__ void finishSM(f32x16& p0, f32x16& p1, float alpha, float& l_reg, bf16x8& pa0, bf16x8& pa1, bf16x8& pa2, bf16x8& pa3) {
#pragma unroll
  for (int r = 0; r < 16; ++r) p1[r] = __builtin_amdgcn_exp2f(p1[r]);
  float ps = 0;
#pragma unroll
  for (int r = 0; r < 16; ++r) ps += p0[r];
#pragma unroll
  for (int r = 0; r < 16; ++r) ps += p1[r];
  { auto rr = __builtin_amdgcn_permlane32_swap(__float_as_uint(ps), __float_as_uint(ps), false, false);
    ps = __uint_as_float(rr[0]) + __uint_as_float(rr[1]); }
  l_reg = l_reg * alpha + ps;
#define PK4(P, B_, OUT) do { unsigned a0 = cvtpk(P[B_+0], P[B_+1]), a1 = cvtpk(P[B_+2], P[B_+3]); \
    unsigned b0 = cvtpk(P[B_+4], P[B_+5]), b1 = cvtpk(P[B_+6], P[B_+7]); \
    auto r0 = __builtin_amdgcn_permlane32_swap(a0, b0, false, false); auto r1 = __builtin_amdgcn_permlane32_swap(a1, b1, false, false); \
    u32x4 w = {r0[0], r1[0], r0[1], r1[1]}; OUT = *reinterpret_cast<bf16x8*>(&w); } while (0)
  PK4(p0, 0, pa0); PK4(p0, 8, pa1); PK4(p1, 0, pa2); PK4(p1, 8, pa3);
#undef PK4
}
template <int KB, class F>
__device__ __forceinline__ void qkt(f32x16& p0, f32x16& p1, const int (&kb)[8], const bf16x8* qr, const f32x16& msp, F issue_dma) {
  constexpr int KOFF = KB * SHM_K;
#define KRD(dst, base, off) asm volatile("ds_read_b128 %0, %1 offset:%2" : "=&v"(dst) : "v"(base), "i"(off) : "memory")
#define KPAIR(d) KRD(ka##d, kb[(d) < 8 ? ((d) & 3) : (d) - 4], KOFF + ((d) < 8 ? ((d) >> 2) * 128 : 0)); KRD(kc##d, kb[(d) < 8 ? ((d) & 3) : (d) - 4], KOFF + ((d) < 8 ? ((d) >> 2) * 128 + 8192 : 4096))
#define KMMA(d) p0 = __builtin_amdgcn_mfma_f32_32x32x16_bf16(ka##d, qr[d], p0, 0, 0, 0); p1 = __builtin_amdgcn_mfma_f32_32x32x16_bf16(kc##d, qr[d], p1, 0, 0, 0)
#define KMMA0() p0 = __builtin_amdgcn_mfma_f32_32x32x16_bf16(ka0, qr[0], msp, 0, 0, 0); p1 = __builtin_amdgcn_mfma_f32_32x32x16_bf16(kc0, qr[0], msp, 0, 0, 0)
#define LW(n) asm volatile("s_waitcnt lgkmcnt(" #n ")" ::: "memory"); SBAR()
  bf16x8 ka0, ka1, ka2, ka3, ka4, ka5, ka6, ka7, ka8, ka9, ka10, ka11, kc0, kc1, kc2, kc3, kc4, kc5, kc6, kc7, kc8, kc9, kc10, kc11;
  KPAIR(0); KPAIR(1); KPAIR(2);
  issue_dma();
  KPAIR(3); LW(6); KMMA0();
  KPAIR(4); LW(6); KMMA(1);
  KPAIR(5); LW(6); KMMA(2);
  KPAIR(6); LW(6); KMMA(3);
  KPAIR(7); LW(6); KMMA(4);
  KPAIR(8); LW(6); KMMA(5);
  KPAIR(9); LW(6); KMMA(6);
  KPAIR(10); LW(6); KMMA(7);
  KPAIR(11); LW(6); KMMA(8);
  LW(4); KMMA(9); LW(2); KMMA(10); LW(0); KMMA(11);
#undef KRD
#undef KPAIR
#undef KMMA
#undef KMMA0
#undef LW
}
template <int VB>
__device__ __forceinline__ void pv_tile(f32x16* o, int vb0, bf16x8 pa0, bf16x8 pa1, bf16x8 pa2, bf16x8 pa3) {
#define TRRD(dst, off) asm volatile("ds_read_b64_tr_b16 %0, %1 offset:%2" : "=&v"(dst) : "v"(vb0), "i"(off) : "memory")
#define VRD8(P, d0) do { constexpr int b_ = VB * SHM_V + v_rd_off(d0, 0, 0); \
    TRRD(P##l0, b_); TRRD(P##h0, b_ + 2048); TRRD(P##l1, b_ + 4096); TRRD(P##h1, b_ + 6144); TRRD(P##l2, b_ + 8192); TRRD(P##h2, b_ + 10240); TRRD(P##l3, b_ + 12288); TRRD(P##h3, b_ + 14336); } while (0)
#define VMMA(P, d0) do { \
    o[d0] = __builtin_amdgcn_mfma_f32_32x32x16_bf16(pa0, (bf16x8){P##l0[0], P##l0[1], P##l0[2], P##l0[3], P##h0[0], P##h0[1], P##h0[2], P##h0[3]}, o[d0], 0, 0, 0); \
    o[d0] = __builtin_amdgcn_mfma_f32_32x32x16_bf16(pa1, (bf16x8){P##l1[0], P##l1[1], P##l1[2], P##l1[3], P##h1[0], P##h1[1], P##h1[2], P##h1[3]}, o[d0], 0, 0, 0); \
    o[d0] = __builtin_amdgcn_mfma_f32_32x32x16_bf16(pa2, (bf16x8){P##l2[0], P##l2[1], P##l2[2], P##l2[3], P##h2[0], P##h2[1], P##h2[2], P##h2[3]}, o[d0], 0, 0, 0); \
    o[d0] = __builtin_amdgcn_mfma_f32_32x32x16_bf16(pa3, (bf16x8){P##l3[0], P##l3[1], P##l3[2], P##l3[3], P##h3[0], P##h3[1], P##h3[2], P##h3[3]}, o[d0], 0, 0, 0); } while (0)
#define LW(n) asm volatile("s_waitcnt lgkmcnt(" #n ")" ::: "memory"); SBAR()
  s16x4 xl0, xl1, xl2, xl3, xh0, xh1, xh2, xh3, yl0, yl1, yl2, yl3, yh0, yh1, yh2, yh3;
  VRD8(x, 0); VRD8(y, 1); LW(8); VMMA(x, 0);
  VRD8(x, 2); LW(8); VMMA(y, 1);
  VRD8(y, 3); LW(8); VMMA(x, 2);
  LW(0); VMMA(y, 3);
#undef TRRD
#undef VRD8
#undef VMMA
#undef LW
}

struct BlockRef { const bf16* Q; const bf16* K; const bf16* KR; const bf16* V; bf16* O; const float* CS; const float* SN; int P0; };

#define LD8(p) (*reinterpret_cast<const bf16x8*>(p))
#define VMW() asm volatile("s_waitcnt vmcnt(0)" ::: "memory")
#define DMA_TILE(k0, bf) do { \
    _Pragma("unroll") for (int p_ = 0; p_ < 2; ++p_) \
      __builtin_amdgcn_global_load_lds((const unsigned*)(cur.K + (size_t)(k0) * DN + koff[p_]), (__attribute__((address_space(3))) unsigned*)(K_lds + (bf) * SHM_K + p_ * 8192 + tid * 16), 16, 0, 0); \
    __builtin_amdgcn_global_load_lds((const unsigned*)(cur.KR + (size_t)(k0) * DR + roff), (__attribute__((address_space(3))) unsigned*)(K_lds + (bf) * SHM_K + 16384 + tid * 16), 16, 0, 0); \
    _Pragma("unroll") for (int p_ = 0; p_ < 2; ++p_) \
      __builtin_amdgcn_global_load_lds((const unsigned*)(cur.V + (size_t)(k0) * DV + vofd[p_]), (__attribute__((address_space(3))) unsigned*)(V_lds + (bf) * SHM_V + p_ * 8192 + tid * 16), 16, 0, 0); } while (0)

__device__ __forceinline__ void attn_block(const BlockRef& cur, char* lds, int wave_s) {
  const int tid = phase_tid(wave_s);
  const int wid = __builtin_amdgcn_readfirstlane(tid >> 6), lane = tid & 63, r32 = lane & 31, hi = lane >> 5;
  unsigned koff[2], vofd[2], roff;
#pragma unroll
  for (int p = 0; p < 2; ++p) { const int b_ = p * 8192 + tid * 16, row = b_ >> 8, pos = (b_ & 255) >> 4;
    const int c = (pos & 8) | ((pos & 7) ^ (row & 7)); koff[p] = row * DN + c * 8; }
  { const int b_ = tid * 16, row = b_ >> 7, pos = (b_ & 127) >> 4; roff = row * DR + (pos ^ (row & 7)) * 8; }
#pragma unroll
  for (int p = 0; p < 2; ++p) { const int b_ = p * 8192 + tid * 16, sub = b_ >> 9, kk = (sub >> 2) * 8 + ((b_ & 511) >> 6), c = (sub & 3) * 32 + ((b_ & 63) >> 1);
    (void)kk; (void)c; vofd[p] = b_ >> 1; }
  char* V_lds = lds; char* K_lds = lds + 2 * SHM_V;
  const int NT = cur.P0 / KVBLK + 4;
  const int qlo = cur.P0 + wid * QBLK, qm = qlo + r32 - 4 * hi;
  float* ws = (float*)(lds + 2 * SHM_V + 2 * SHM_K) + wid * 64; float* li_l = ws, * al_l = ws + 32;
  const int vb0 = (int)(uintptr_t)V_lds + v_rd_base(lane);
  int kb[8];
#pragma unroll
  for (int dd = 0; dd < 4; ++dd) { const int x_ = (dd * 32 + hi * 16) ^ ((r32 & 7) << 4); kb[dd] = (int)(uintptr_t)K_lds + r32 * 256 + x_; kb[4 + dd] = (int)(uintptr_t)K_lds + 16384 + r32 * 128 + x_; }
  bf16x8 qr[12];
#pragma unroll
  for (int d0 = 0; d0 < 12; ++d0) qr[d0] = LD8(cur.Q + (size_t)(wid * QBLK + r32) * DQK + d0 * 16 + hi * 8);
  DMA_TILE(0, 0);
#pragma unroll
  for (int dd = 0; dd < 2; ++dd) {
    const float* cp = cur.CS + (size_t)(wid * QBLK + r32) * 32 + dd * 16 + hi * 8; const float* sp = cur.SN + (size_t)(wid * QBLK + r32) * 32 + dd * 16 + hi * 8;
    const f32x4 c0 = *(const f32x4*)cp, c1 = *(const f32x4*)(cp + 4), s0 = *(const f32x4*)sp, s1 = *(const f32x4*)(sp + 4);
    const bf16x8 qa = qr[8 + dd], qb = qr[10 + dd]; f32x4 na0, na1, nb0, nb1;
#pragma unroll
    for (int j = 0; j < 4; ++j) { const float a0 = bf2f((unsigned short)qa[j]), b0 = bf2f((unsigned short)qb[j]), a1 = bf2f((unsigned short)qa[4 + j]), b1 = bf2f((unsigned short)qb[4 + j]);
      na0[j] = a0 * c0[j] - b0 * s0[j]; nb0[j] = b0 * c0[j] + a0 * s0[j]; na1[j] = a1 * c1[j] - b1 * s1[j]; nb1[j] = b1 * c1[j] + a1 * s1[j]; }
    qr[8 + dd] = pack8(na0, na1); qr[10 + dd] = pack8(nb0, nb1); }
  VMW();
  __syncthreads();
  float m_reg = 0.f, l_reg = 0; f32x16 o[4] = {}; f32x16 msp = {};
#define RESC(a) do { if (__any((a) < 1.f)) { if (hi == 0) al_l[r32] = (a); asm volatile("s_waitcnt lgkmcnt(0)" ::: "memory"); \
    for (int d_ = 0; d_ < 4; ++d_) for (int r = 0; r < 16; ++r) o[d_][r] *= al_l[crow(r, hi)]; } } while (0)
#define STEP(t, KB) do { f32x16 p0, p1; float al; bf16x8 pa0, pa1, pa2, pa3; \
    SBAR(); qkt<KB>(p0, p1, kb, qr, msp, [&]() { if ((t) + 1 < NT) { DMA_TILE(((t) + 1) * KVBLK, 1 - KB); } }); \
    { const int kb_ = (t) * KVBLK; if (kb_ + KVBLK - 1 > qlo) mask_tile(p0, p1, qm - kb_); } \
    partialSM(p0, p1, m_reg, al, (t) == 0, msp); RESC(al); \
    finishSM(p0, p1, al, l_reg, pa0, pa1, pa2, pa3); SBAR(); \
    pv_tile<KB>(o, vb0, pa0, pa1, pa2, pa3); SBAR(); \
    VMW(); __syncthreads(); SBAR(); } while (0)
  for (int t = 0; t < NT; t += 2) { STEP(t, 0); STEP(t + 1, 1); }
  if (hi == 0) li_l[r32] = l_reg; asm volatile("s_waitcnt lgkmcnt(0)" ::: "memory");
  float rli[16];
#pragma unroll
  for (int r = 0; r < 16; ++r) rli[r] = __builtin_amdgcn_rcpf(li_l[crow(r, hi)]);
  bf16* Ow = cur.O + (size_t)(wid * QBLK) * PW;
#pragma unroll
  for (int r = 0; r < 16; ++r) { const int orow = crow(r, hi);
#pragma unroll
    for (int d0 = 0; d0 < 4; ++d0) { const float v = o[d0][r] * rli[r];
      const float vn = DPP_F(v, 0xB1);
      if ((r32 & 1) == 0) *(unsigned*)(Ow + (size_t)orow * PW + d0 * 32 + r32) = cvtpk(v, vn); } }
  __syncthreads();
#undef RESC
#undef STEP
}

__device__ __forceinline__ BlockRef att_ref(int b, int h, int qb, const bf16* Qb, const bf16* Kb, const bf16* Vb, const bf16* kr, bf16* O, const float* cs, const float* sn) {
  BlockRef r;
  r.Q = Qb + ((size_t)h * S + (size_t)qb * QB) * DQK;
  r.K = Kb + (size_t)h * S * DN; r.V = Vb + (size_t)h * S * DV; r.KR = kr + (size_t)b * S * DR;
  r.O = O + ((size_t)b * S + (size_t)qb * QB) * PW + h * DV; r.P0 = qb * QB;
  r.CS = cs + ((size_t)b * S + (size_t)qb * QB) * 32; r.SN = sn + ((size_t)b * S + (size_t)qb * QB) * 32;
  return r;
}
__device__ __forceinline__ void attn_phase(int b, const bf16* Qb, const bf16* Kb, const bf16* Vb, const bf16* kr, bf16* O, const float* cs, const float* sn, char* lds, int wave_s) {
  constexpr int total = NH * 32;
  for (int L = blockIdx.x; L < total; L += gridDim.x) {
    const int pass = L / (NH * 16), Lp = L % (NH * 16);
    const int xcd = Lp & 7, k = Lp >> 3, h = xcd * 2 + (k >> 4), x = k & 15;
    const int qb = pass ? x : 31 - x;
    const BlockRef cur = att_ref(b, h, qb, Qb, Kb, Vb, kr, O, cs, sn);
    attn_block(cur, lds, wave_s);
  }
}

__device__ __forceinline__ void tr_matrix(const float* __restrict__ src, int K, int N, bf16* __restrict__ dst, bool sw, float* tile, int& cursor, int wave_s) {
  (void)sw;
  const int tid = phase_tid(wave_s);
  const int nk = K / 64, nn = N / 64, ntile = nk * nn;
  int i = (blockIdx.x + gridDim.x - (cursor % gridDim.x)) % gridDim.x;
  cursor += ntile;
  const int lr = tid >> 4, lc4 = (tid & 15) * 4;
  f32x4 v0 = {}, v1 = {};
  if (i < ntile) { const float* p = src + (size_t)((i / nn) * 64 + lr) * N + (i % nn) * 64 + lc4; v0 = __builtin_nontemporal_load((const f32x4*)p); v1 = __builtin_nontemporal_load((const f32x4*)(p + (size_t)32 * N)); }
  while (i < ntile) {
    const int k0 = (i / nn) * 64, n0 = (i % nn) * 64;
#pragma unroll
    for (int e = 0; e < 4; ++e) { tile[lr * 65 + lc4 + e] = v0[e]; tile[(lr + 32) * 65 + lc4 + e] = v1[e]; }
    __syncthreads();
    const int inext = i + gridDim.x;
    if (inext < ntile) { const float* p = src + (size_t)((inext / nn) * 64 + lr) * N + (inext % nn) * 64 + lc4; v0 = __builtin_nontemporal_load((const f32x4*)p); v1 = __builtin_nontemporal_load((const f32x4*)(p + (size_t)32 * N)); }
    { const int n = tid >> 3, kk = (tid & 7) * 8;
      f32x4 a, b2;
      a[0] = tile[(kk + 0) * 65 + n]; a[1] = tile[(kk + 1) * 65 + n]; a[2] = tile[(kk + 2) * 65 + n]; a[3] = tile[(kk + 3) * 65 + n];
      b2[0] = tile[(kk + 4) * 65 + n]; b2[1] = tile[(kk + 5) * 65 + n]; b2[2] = tile[(kk + 6) * 65 + n]; b2[3] = tile[(kk + 7) * 65 + n];
      *(bf16x8*)(dst + (size_t)(n0 + n) * K + k0 + kk) = pack8(a, b2); }
    __syncthreads();
    i = inext;
  }
}
template <bool OUT_BF16>
__device__ __forceinline__ void rmsnorm_rows(const float* x, const float* __restrict__ g, bf16* out, float* outf, int wave_s) {
  const int tid_ = phase_tid(wave_s);
  const int wid = tid_ >> 6, lane = tid_ & 63;
  const int stride = gridDim.x * 8;
  int row = blockIdx.x * 8 + wid;
  f32x4 va[4], vb[4], na[4], nb[4];
#define RMS_LOAD(A_, B_, r_) do { const int r2_ = (r_) + stride; const f32x4* xa_ = (const f32x4*)(x + (size_t)(r_) * DM); const f32x4* xb_ = (const f32x4*)(x + (size_t)(r2_ < T ? r2_ : (r_)) * DM); \
    _Pragma("unroll") for (int i = 0; i < 4; ++i) A_[i] = __builtin_nontemporal_load(xa_ + lane + 64 * i); _Pragma("unroll") for (int i = 0; i < 4; ++i) B_[i] = __builtin_nontemporal_load(xb_ + lane + 64 * i); } while (0)
  if (row < T) RMS_LOAD(va, vb, row);
  while (row < T) {
    const int row2 = row + stride, rown = row + 2 * stride; const bool two = row2 < T;
    if (rown < T) RMS_LOAD(na, nb, rown);
    float sa = 0, sb = 0;
#pragma unroll
    for (int i = 0; i < 4; ++i) { sa += va[i][0] * va[i][0] + va[i][1] * va[i][1] + va[i][2] * va[i][2] + va[i][3] * va[i][3];
                                  sb += vb[i][0] * vb[i][0] + vb[i][1] * vb[i][1] + vb[i][2] * vb[i][2] + vb[i][3] * vb[i][3]; }
    sa = wave_sum(sa); sb = wave_sum(sb);
    const float ia = rsqrtf(sa * (1.f / DM) + EPS), ib = rsqrtf(sb * (1.f / DM) + EPS);
#pragma unroll
    for (int i = 0; i < 4; ++i) { const f32x4 gg = ((const f32x4*)g)[lane + 64 * i];
      const f32x4 wa = va[i] * ia * gg, wb = vb[i] * ib * gg;
      if constexpr (OUT_BF16) {
        u32x2 pa = {cvtpk(wa[0], wa[1]), cvtpk(wa[2], wa[3])}; *(u32x2*)(out + (size_t)row * DM + (lane + 64 * i) * 4) = pa;
        if (two) { u32x2 pb = {cvtpk(wb[0], wb[1]), cvtpk(wb[2], wb[3])}; *(u32x2*)(out + (size_t)row2 * DM + (lane + 64 * i) * 4) = pb; } }
      else { ((f32x4*)(outf + (size_t)row * DM))[lane + 64 * i] = wa; if (two) ((f32x4*)(outf + (size_t)row2 * DM))[lane + 64 * i] = wb; } }
#pragma unroll
    for (int i = 0; i < 4; ++i) { va[i] = na[i]; vb[i] = nb[i]; }
    row = rown;
  }
#undef RMS_LOAD
}
__device__ __forceinline__ void rmsnorm_rows_bf16(const float* __restrict__ x, const float* __restrict__ g, bf16* __restrict__ out, int wave_s) { rmsnorm_rows<true>(x, g, out, nullptr, wave_s); }
__device__ __forceinline__ void rmsnorm_rows_f32_inplace(float* x, const float* __restrict__ g, int wave_s) { rmsnorm_rows<false>(x, g, nullptr, x, wave_s); }
__device__ __forceinline__ void rope_tables(const int* __restrict__ pos, float* __restrict__ cs, float* __restrict__ sn, int wave_s) {
  const int tid_ = phase_tid(wave_s);
  for (int idx = blockIdx.x * 512 + tid_; idx < T * 32; idx += gridDim.x * 512) {
    const int t = idx >> 5, i = idx & 31;
    const float inv_freq = __builtin_amdgcn_exp2f(-(float)i * (13.287712379549449f / 32.0f));
    const float ang = (float)pos[t] * inv_freq;
    constexpr float INV2PI = 0.15915494309189535f;
    const float tt = ang * INV2PI, res = fmaf(ang, INV2PI, -tt);
    const float fr = (tt - rintf(tt)) + res;
    cs[idx] = __builtin_amdgcn_cosf(fr); sn[idx] = __builtin_amdgcn_sinf(fr);
  }
}
__device__ __forceinline__ void pool_item(const bf16* __restrict__ u, bf16* __restrict__ pl, int cgx, int t0) {
  {
    const int s0 = t0 & (S - 1);
    const int w = 2 << (cgx >> 6);
    const bf16* up = u + (size_t)t0 * PW + cgx * 8;
    bf16* pp = pl + ((size_t)(cgx >> 6) * T + t0) * 512 + (cgx & 63) * 8;
    float s[8];
#pragma unroll
    for (int e = 0; e < 8; ++e) s[e] = 0.f;
    if (s0 > 0) {
#pragma unroll 4
      for (int d = 1; d <= w; ++d) { const bf16x8 v = LD8(up - (size_t)d * PW);
#pragma unroll
        for (int e = 0; e < 8; ++e) s[e] += bf2f((unsigned short)v[e]); } }
    bf16x8 cv[8], ov[8], cn[8], on[8];
#define POOL_LOAD(C_, O_, i0_) do { \
    _Pragma("unroll") for (int k = 0; k < 8; ++k) C_[k] = LD8(up + (size_t)((i0_) + k) * PW); \
    _Pragma("unroll") for (int k = 0; k < 8; ++k) { const int i = (i0_) + k; O_[k] = LD8(up + (size_t)((s0 + i - w >= 0) ? (i - w) : i) * PW); } } while (0)
    POOL_LOAD(cv, ov, 0);
#pragma unroll
    for (int i0 = 0; i0 < 32; i0 += 8) {
      if (i0 + 8 < 32) POOL_LOAD(cn, on, i0 + 8);
#pragma unroll
      for (int k = 0; k < 8; ++k) { const int i = i0 + k, si = s0 + i; const bool has = si - w >= 0;
        float c[8];
#pragma unroll
        for (int e = 0; e < 8; ++e) { c[e] = bf2f((unsigned short)cv[k][e]); s[e] += c[e]; if (has) s[e] -= bf2f((unsigned short)ov[k][e]); }
        const float rc = 1.f / (float)min(si + 1, w);
        f32x4 a = {s[0] * rc - c[0], s[1] * rc - c[1], s[2] * rc - c[2], s[3] * rc - c[3]};
        f32x4 b2 = {s[4] * rc - c[4], s[5] * rc - c[5], s[6] * rc - c[6], s[7] * rc - c[7]};
        *(bf16x8*)(pp + (size_t)i * 512) = pack8(a, b2); }
#pragma unroll
      for (int k = 0; k < 8; ++k) { cv[k] = cn[k]; ov[k] = on[k]; }
    }
#undef POOL_LOAD
  }
}
__device__ __forceinline__ void pool_phase(const bf16* __restrict__ u, bf16* __restrict__ pl, int wave_s) {
  const int tid_ = phase_tid(wave_s);
  for (int idx = blockIdx.x * 512 + tid_; idx < (T / 32) * 256; idx += gridDim.x * 512) pool_item(u, pl, idx & 255, (idx >> 8) * 32);
}
typedef const __attribute__((address_space(4))) Params* KParams;
#define XB_TMO      128
#define XB_XCNT(j)  (256  + 64 * (j))
#define XB_XSUB(j)  (1280 + 64 * (j))
#define XB_XGEN(j)  (2304 + 64 * (j))
#define XB_TOP      3328
#define XB_TOPGEN   3392
#define XCD_BAR_WORDS 3456
#define XB_SPIN_CAP (1u << 20)
#define LAS __attribute__((address_space(3)))
__device__ __forceinline__ unsigned xb_ld(unsigned* p)              { return __hip_atomic_load(p, __ATOMIC_RELAXED, __HIP_MEMORY_SCOPE_AGENT); }
__device__ __forceinline__ unsigned xb_add(unsigned* p, unsigned v) { return __hip_atomic_fetch_add(p, v, __ATOMIC_RELAXED, __HIP_MEMORY_SCOPE_AGENT); }
__device__ __forceinline__ unsigned xb_xcc_id() { return (unsigned)__builtin_amdgcn_s_getreg((3 << 11) | 20) & 0xFu; }
#define XB_SPIN(cond, bar) do { unsigned _sp = 0; while (cond) { __builtin_amdgcn_s_sleep(1); \
    if ((++_sp & 255u) == 0u) { if (xb_ld(&(bar)[XB_TMO])) break; if (_sp > XB_SPIN_CAP) { atomicAdd(&(bar)[XB_TMO], 1u); break; } } } } while (0)
__device__ __forceinline__ void xcd_barrier_complete(unsigned* bar, unsigned x, unsigned& nloc, unsigned& nx) {
  const unsigned G = gridDim.x;
  unsigned sum, cnt, mine, sp = 0u;
  for (;;) {
    sum = 0u; cnt = 0u; mine = 0u;
#pragma unroll
    for (unsigned j = 0; j < 16; ++j) { const unsigned c = xb_ld(&bar[XB_XCNT(j)]); sum += c; cnt += (c > 0u) ? 1u : 0u; mine = (j == x) ? c : mine; }
    if (sum == G) break;
    __builtin_amdgcn_s_sleep(1);
    if ((++sp & 255u) == 0u) { if (xb_ld(&bar[XB_TMO])) break; if (sp > XB_SPIN_CAP) { atomicAdd(&bar[XB_TMO], 1u); break; } }
  }
  nloc = mine > 0u ? mine : 1u; nx = cnt > 0u ? cnt : 1u;
}
__device__ __forceinline__ void xcd_barrier(unsigned* bar, volatile LAS unsigned* st, int wave_s) {
  asm volatile("s_waitcnt vmcnt(0)" ::: "memory");
  __syncthreads();
  if (phase_tid(wave_s) == 0) {
    const unsigned x = xb_xcc_id();
    __builtin_amdgcn_s_waitcnt(0);
    unsigned nloc = st[0], nx = st[1];
    if (nloc == 0u) { xcd_barrier_complete(bar, x, nloc, nx); st[0] = nloc; st[1] = nx; }
    const unsigned old = xb_add(&bar[XB_XSUB(x)], 1u);
    const unsigned gen = old / nloc;
    if (old + 1u == (gen + 1u) * nloc) {
      __builtin_amdgcn_fence(__ATOMIC_RELEASE, "agent");
      asm volatile("s_waitcnt vmcnt(0)" ::: "memory");
      const unsigned og = xb_add(&bar[XB_TOP], 1u);
      const unsigned tg = og / nx;
      if (og + 1u == (tg + 1u) * nx) xb_add(&bar[XB_TOPGEN], 1u);
      else XB_SPIN(xb_ld(&bar[XB_TOPGEN]) == tg, bar);
      __builtin_amdgcn_fence(__ATOMIC_ACQUIRE, "agent");
      xb_add(&bar[XB_XGEN(x)], 1u);
      asm volatile("s_waitcnt vmcnt(0)" ::: "memory");
    } else {
      XB_SPIN(xb_ld(&bar[XB_XGEN(x)]) == gen, bar);
      __builtin_amdgcn_fence(__ATOMIC_ACQUIRE, "agent");
      asm volatile("s_waitcnt vmcnt(0)" ::: "memory");
    }
  }
  __syncthreads();
}
#define PHASE_PTRS KParams P_ = kp; asm volatile("" : "+s"(P_)); Params p; p.x = P_->x; p.pos = P_->pos; p.pool_norm = P_->pool_norm; p.pool_w_in = P_->pool_w_in; p.pool_w_group = P_->pool_w_group; p.pool_scale = P_->pool_scale; p.pool_w_out = P_->pool_w_out; p.mla_norm = P_->mla_norm; p.mla_w_in = P_->mla_w_in; p.mla_q_norm = P_->mla_q_norm; p.mla_w_q_b = P_->mla_w_q_b; p.mla_kv_norm = P_->mla_kv_norm; p.mla_w_kv_b = P_->mla_w_kv_b; p.mla_w_out = P_->mla_w_out; p.final_norm = P_->final_norm; p.out = P_->out; p.ws = P_->ws; unsigned char* ws = p.ws; \
  bf16* w_in1 = (bf16*)(ws + WS_WIN1); bf16* w_q = (bf16*)(ws + WS_WQ); bf16* w_kv = (bf16*)(ws + WS_WKV); bf16* w_o1 = (bf16*)(ws + WS_WO1); \
  float* cs = (float*)(ws + WS_COS); float* sn = (float*)(ws + WS_SIN); \
  bf16* w_in0 = (bf16*)(ws + WS_WIN0); bf16* w_g = (bf16*)(ws + WS_WG); bf16* w_o0 = (bf16*)(ws + WS_WO0); \
  bf16* h0 = (bf16*)(ws + WS_H0); bf16* u = (bf16*)(ws + WS_U); bf16* yb = (bf16*)(ws + WS_U); bf16* sz = (bf16*)(ws + WS_SZ); bf16* pl = (bf16*)(ws + WS_PL); \
  bf16* h1 = (bf16*)(ws + WS_H1); bf16* qn = (bf16*)(ws + WS_QN); bf16* kvn = (bf16*)(ws + WS_KVN); bf16* kr = (bf16*)(ws + WS_KR); \
  bf16* ob = (bf16*)(ws + WS_O); bf16* Qb = (bf16*)(ws + WS_QB); bf16* Kb = (bf16*)(ws + WS_KB); bf16* Vb = (bf16*)(ws + WS_VB); \
  float* ss1 = (float*)(ws + WS_SS1); float* ssq = (float*)(ws + WS_SSQ); float* ssk = (float*)(ws + WS_SSK);

template <int MASK>
__global__ void __launch_bounds__(512, 2) fwd_kernel(Params p_unused, int b_arg) {
  constexpr bool FUSED = MASK == 0x3fff;
  extern __shared__ __attribute__((aligned(16))) char lds[];
  const int wave_s = __builtin_amdgcn_readfirstlane((int)threadIdx.x >> 6);
  volatile LAS unsigned* xb_st = (volatile LAS unsigned*)(lds + LDS_MAIN);
  KParams kp = (KParams)__builtin_amdgcn_kernarg_segment_ptr();
  if constexpr (FUSED) {
    unsigned* bar0 = (unsigned*)(kp->ws + WS_BAR);
    if (threadIdx.x == 0) { xb_st[0] = 0u; xb_st[1] = 0u;
      (void)xb_add(bar0 + XB_XCNT(xb_xcc_id()), 1u); }
    __syncthreads();
  }
  bf16* shm = (bf16*)lds;
  if constexpr ((MASK >> 0) & 1) { PHASE_PTRS
  { int cur = 0; float* tile = (float*)lds;
    tr_matrix(p.pool_w_in, DM, 2 * PW, w_in0, false, tile, cur, wave_s);
    for (int g = 0; g < 4; ++g) tr_matrix(p.pool_w_group + (size_t)g * 512 * 512, 512, 512, w_g + (size_t)g * 512 * 512, false, tile, cur, wave_s);
    tr_matrix(p.pool_w_out, PW, DM, w_o0, false, tile, cur, wave_s);
    tr_matrix(p.mla_w_in, DM, MLA_IN, w_in1, false, tile, cur, wave_s);
    tr_matrix(p.mla_w_q_b, QL, NH * DQK, w_q, false, tile, cur, wave_s);
    tr_matrix(p.mla_w_kv_b, KVL, NH * (DN + DV), w_kv, false, tile, cur, wave_s);
    tr_matrix(p.mla_w_out, PW, DM, w_o1, false, tile, cur, wave_s);
    rope_tables(p.pos, cs, sn, wave_s);
    rmsnorm_rows_bf16(p.x, p.pool_norm, h0, wave_s); }
  }
  if constexpr (FUSED) { KParams P_ = kp; asm volatile("" : "+s"(P_)); xcd_barrier((unsigned*)(P_->ws + WS_BAR), xb_st, wave_s); }
  if constexpr ((MASK >> 1) & 1) { PHASE_PTRS
  { constexpr int nM = T / 256, nN = (2 * PW) / 256;
    for (int w = blockIdx.x; w < nM * nN; w += gridDim.x) { int pm, pn; tile_map(w, nM, nN, pm, pn);
      gemm_tile<DM, DM, DM>(h0, w_in0, pm * 256, pn * 256, shm, wave_s, NOCPRE, NOPRE, [&](EPI_ARGS) {
        if (col < PW) *(bf16x8*)(u + (size_t)row * PW + col) = pack8(lo, hi);
        else { UNR for (int e = 0; e < 4; ++e) { lo[e] = silu_f(lo[e]); hi[e] = silu_f(hi[e]); }
          *(bf16x8*)(sz + (size_t)row * PW + col - PW) = pack8(lo, hi); } }); } }
  }
  if constexpr (FUSED) { KParams P_ = kp; asm volatile("" : "+s"(P_)); xcd_barrier((unsigned*)(P_->ws + WS_BAR), xb_st, wave_s); }
  if constexpr (!FUSED && ((MASK >> 2) & 1)) { PHASE_PTRS
  pool_phase(u, pl, wave_s);
  }
  if constexpr ((MASK >> 3) & 1) { PHASE_PTRS
  { const float* scale = p.pool_scale;
    constexpr int NU = FUSED ? 256 : 512;
    for (int w = blockIdx.x; w < NU; w += gridDim.x) {
      int g, pm, pn0, pn1;
      if constexpr (FUSED) { g = w >> 6; pm = w & 63; pn0 = 0; pn1 = 2;
        const int tid_ = phase_tid(wave_s);
        pool_item(u, pl, g * 64 + (tid_ & 63), (pm * 8 + (tid_ >> 6)) * 32);
        asm volatile("s_waitcnt vmcnt(0)" ::: "memory");
        __syncthreads(); }
      else { g = w >> 7; const int wi = w & 127; pm = wi >> 1; pn0 = wi & 1; pn1 = pn0 + 1; }
      for (int pn = pn0; pn < pn1; ++pn)
      gemm_tile<512, 512, 512>(pl + (size_t)g * T * 512, w_g + (size_t)g * 512 * 512, pm * 256, pn * 256, shm, wave_s,
        [&](int col) { Pre r; r.a = *(const f32x4*)(scale + g * 512 + col); r.b = *(const f32x4*)(scale + g * 512 + col + 4); return r; },
        [&](int row, int col) { Pre r; r.a = *(const f32x4*)(sz + (size_t)row * PW + g * 512 + col); r.b = f32x4{}; return r; },
        [&](EPI_ARGS) {
        const int c = g * 512 + col; const size_t ix = (size_t)row * PW + c;
        const bf16x8 zz = *reinterpret_cast<const bf16x8*>(&pv.a); const f32x4 s0 = cp.a, s1 = cp.b;
        UNR for (int e = 0; e < 4; ++e) { lo[e] *= s0[e] * bf2f((unsigned short)zz[e]); hi[e] *= s1[e] * bf2f((unsigned short)zz[4 + e]); }
        *(bf16x8*)(yb + ix) = pack8(lo, hi); }); } }
  }
  if constexpr (FUSED) { KParams P_ = kp; asm volatile("" : "+s"(P_)); xcd_barrier((unsigned*)(P_->ws + WS_BAR), xb_st, wave_s); }
  if constexpr ((MASK >> 4) & 1) { PHASE_PTRS
  { constexpr int nM = T / 256, nN = DM / 256; const float* x = p.x; float* out = p.out; const float* gm = p.mla_norm;
    for (int w = blockIdx.x; w < nM * nN; w += gridDim.x) { int pm, pn; tile_map(w, nM, nN, pm, pn);
      gemm_tile<PW, PW, PW>(yb, w_o0, pm * 256, pn * 256, shm, wave_s,
        [&](int col) { Pre r; r.a = *(const f32x4*)(gm + col); r.b = *(const f32x4*)(gm + col + 4); return r; },
        [&](int row, int col) { Pre r; const size_t ix = (size_t)row * DM + col; r.a = *(const f32x4*)(x + ix); r.b = *(const f32x4*)(x + ix + 4); return r; },
        [&](EPI_ARGS) {
        const size_t ix = (size_t)row * DM + col; const f32x4 x0 = pv.a + lo, x1 = pv.b + hi;
        *(f32x4*)(out + ix) = x0; *(f32x4*)(out + ix + 4) = x1;
        *(bf16x8*)(h1 + ix) = pack8(x0 * cp.a, x1 * cp.b);
        const float sq = half_sum(dot8(x0, x1));
        if ((col & 255) == 0) ss1[(size_t)row * 4 + (col >> 8)] = sq; }); } }
  }
  if constexpr (FUSED) { KParams P_ = kp; asm volatile("" : "+s"(P_)); xcd_barrier((unsigned*)(P_->ws + WS_BAR), xb_st, wave_s); }
  if constexpr ((MASK >> 6) & 1) { PHASE_PTRS
  { constexpr int nM = T / 256, nN = 3; const float* gq = p.mla_q_norm; const float* gkv = p.mla_kv_norm;
    for (int w = blockIdx.x; w < nM * nN; w += gridDim.x) { int pm, pn; tile_map(w, nM, nN, pm, pn);
      gemm_tile<DM, DM, DM>(h1, w_in1, pm * 256, pn * 256, shm, wave_s,
        [&](int col) { Pre r{}; if (col < QL) { r.a = *(const f32x4*)(gq + col); r.b = *(const f32x4*)(gq + col + 4); } else if (col < LATW) { r.a = *(const f32x4*)(gkv + col - QL); r.b = *(const f32x4*)(gkv + col - QL + 4); } return r; },
        [&](int row, int col) { Pre r; r.a = *(const f32x4*)(ss1 + (size_t)row * 4); r.b = f32x4{}; return r; },
        [&](EPI_ARGS) {
        const f32x4 s4 = pv.a; const float inv1 = rsqrtf((s4[0] + s4[1] + s4[2] + s4[3]) * (1.f / DM) + EPS);
        lo *= inv1; hi *= inv1;
        float sq = 0.f, sk = 0.f;
        if (col < QL) { sq = dot8(lo, hi);
          *(bf16x8*)(qn + (size_t)row * QL + col) = pack8(lo * cp.a, hi * cp.b); }
        else if (col < LATW) { sk = dot8(lo, hi); const int c = col - QL;
          *(bf16x8*)(kvn + (size_t)row * KVL + c) = pack8(lo * cp.a, hi * cp.b); }
        else if (col < LATW + DR) { const int i0 = col - LATW, fi = i0 & 31;
          const float* pp = ctp + (i0 < 32 ? 32 : -32); const f32x4 pl = *(const f32x4*)pp * inv1, ph = *(const f32x4*)(pp + 4) * inv1;
          const float* cp = cs + (size_t)row * 32 + fi; const float* sp = sn + (size_t)row * 32 + fi;
          const f32x4 c0 = *(const f32x4*)cp, c1 = *(const f32x4*)(cp + 4), s0 = *(const f32x4*)sp, s1 = *(const f32x4*)(sp + 4);
          f32x4 o0, o1; if (i0 < 32) { o0 = lo * c0 - pl * s0; o1 = hi * c1 - ph * s1; } else { o0 = lo * c0 + pl * s0; o1 = hi * c1 + ph * s1; }
          *(bf16x8*)(kr + (size_t)row * DR + i0) = pack8(o0, o1); }
        sq = half_sum(sq); sk = half_sum(sk);
        if ((col & 255) == 0) { const int pn_ = col >> 8; if (pn_ < 2) ssq[(size_t)row * 2 + pn_] = sq; if (pn_ >= 1) ssk[(size_t)row * 2 + pn_ - 1] = sk; } }); } }
  }
  if constexpr (FUSED) { KParams P_ = kp; asm volatile("" : "+s"(P_)); xcd_barrier((unsigned*)(P_->ws + WS_BAR), xb_st, wave_s); }
  for (int b = FUSED ? 0 : b_arg; b < (FUSED ? NB : b_arg + 1); ++b) {
  constexpr bool P8_BOTH = ((MASK >> 8) & 1) && ((MASK >> 13) & 1);
  for (int pass = 0; pass < (P8_BOTH ? 2 : 1); ++pass) {
  const bool swapped = P8_BOTH && ((blockIdx.x >> 3) & 1);
  const bool run_q = !P8_BOTH || ((pass == 0) != swapped), run_kv = !P8_BOTH || ((pass == 1) != swapped);
  if constexpr ((MASK >> 8) & 1) { if (run_q) { PHASE_PTRS
    { constexpr int nMb = S / 256, nq = nMb * 12;
      const bf16* qa = qn + (size_t)b * S * QL;
      for (int w = blockIdx.x; w < nq; w += gridDim.x) {
        { int pm, pn; tile_map(w, nMb, 12, pm, pn);
          gemm_tile<QL, QL, QL>(qa, w_q, pm * 256, pn * 256, shm, wave_s, NOCPRE,
            [&](int row, int col) { Pre r{}; const float* sp = ssq + ((size_t)b * S + row) * 2; r.a[0] = sp[0]; r.a[1] = sp[1]; return r; },
            [&](EPI_ARGS) {
            const float inv = rsqrtf((pv.a[0] + pv.a[1]) * (1.f / QL) + EPS) * (SM_SCALE * 1.4426950408889634f);
            const int hh = col / DQK, d = col - hh * DQK;
            *(bf16x8*)(Qb + ((size_t)hh * S + row) * DQK + d) = pack8(lo * inv, hi * inv); }); }
      } }
  } }
    if constexpr ((MASK >> 13) & 1) { if (run_kv) { PHASE_PTRS
    { constexpr int nMb = S / 256, nkv = nMb * 16; const bf16* ka = kvn + (size_t)b * S * KVL;
      for (int w = blockIdx.x; w < nkv; w += gridDim.x) {
        { int pm, pn; tile_map(w, nMb, 16, pm, pn);
          gemm_tile<KVL, KVL, KVL>(ka, w_kv, pm * 256, pn * 256, shm, wave_s, NOCPRE,
            [&](int row, int col) { Pre r{}; const float* sp = ssk + ((size_t)b * S + row) * 2; r.a[0] = sp[0]; r.a[1] = sp[1]; return r; },
            [&](EPI_ARGS) {
            const float inv = rsqrtf((pv.a[0] + pv.a[1]) * (1.f / KVL) + EPS);
            const int hh = col >> 8, wi = col & 255;
            bf16* d;
            if (wi < 128) d = Kb + wi + ((size_t)hh * S + row) * 128;
            else { const int c = wi - 128, k = row & 63;
              d = Vb + ((size_t)hh * S + (row - k)) * 128 + (v_st(k, c) >> 1); }
            *(bf16x8*)d = pack8(lo * inv, hi * inv); }); } } }
  } }
  }
    if constexpr (FUSED) { KParams P_ = kp; asm volatile("" : "+s"(P_)); xcd_barrier((unsigned*)(P_->ws + WS_BAR), xb_st, wave_s); }
  if constexpr ((MASK >> 9) & 1) { PHASE_PTRS
    attn_phase(b, Qb, Kb, Vb, kr, ob, cs, sn, lds, wave_s);
  }
    if constexpr (FUSED) { KParams P_ = kp; asm volatile("" : "+s"(P_)); xcd_barrier((unsigned*)(P_->ws + WS_BAR), xb_st, wave_s); }
  }
  if constexpr ((MASK >> 10) & 1) { PHASE_PTRS
  { constexpr int nM = T / 256, nN = PW / 256;
    for (int w = blockIdx.x; w < nM * nN; w += gridDim.x) { int pm, pn; tile_map(w, nM, nN, pm, pn);
      gemm_tile<DM, DM, DM>(h1, w_in1 + (size_t)(LATW + DR) * DM, pm * 256, pn * 256, shm, wave_s, NOCPRE,
        [&](int row, int col) { Pre r; r.a = *(const f32x4*)(ob + (size_t)row * PW + col); r.b = *(const f32x4*)(ss1 + (size_t)row * 4); return r; },
        [&](EPI_ARGS) {
        const f32x4 s4 = pv.b; const float inv1 = rsqrtf((s4[0] + s4[1] + s4[2] + s4[3]) * (1.f / DM) + EPS);
        lo *= inv1; hi *= inv1;
        bf16* d = ob + (size_t)row * PW + col; const bf16x8 ov = *reinterpret_cast<const bf16x8*>(&pv.a);
        UNR for (int e = 0; e < 4; ++e) { lo[e] = silu_f(lo[e]) * bf2f((unsigned short)ov[e]); hi[e] = silu_f(hi[e]) * bf2f((unsigned short)ov[4 + e]); }
        *(bf16x8*)d = pack8(lo, hi); }); } }
  }
  if constexpr (FUSED) { KParams P_ = kp; asm volatile("" : "+s"(P_)); xcd_barrier((unsigned*)(P_->ws + WS_BAR), xb_st, wave_s); }
  bool fused_tail = false;
  if constexpr (FUSED) { fused_tail = gridDim.x >= 256;
    if (fused_tail) { PHASE_PTRS
      constexpr int nM = T / 256, nN = DM / 256; int pm = 0, pn = 0; const bool active = blockIdx.x < nM * nN;
      if (active) tile_map(blockIdx.x, nM, nN, pm, pn);
      final_tile(active, ob, w_o1, pm * 256, pn * 256, shm, wave_s, p.out, ss1, p.final_norm,
                 [&]() { KParams P_ = kp; asm volatile("" : "+s"(P_)); xcd_barrier((unsigned*)(P_->ws + WS_BAR), xb_st, wave_s); }); } }
  if (!fused_tail) {
  if constexpr ((MASK >> 11) & 1) { PHASE_PTRS
  { constexpr int nM = T / 256, nN = DM / 256; float* out = p.out;
    for (int w = blockIdx.x; w < nM * nN; w += gridDim.x) { int pm, pn; tile_map(w, nM, nN, pm, pn);
      gemm_tile<PW, PW, PW>(ob, w_o1, pm * 256, pn * 256, shm, wave_s, NOCPRE,
        [&](int row, int col) { Pre r; const float* d = out + (size_t)row * DM + col; r.a = *(const f32x4*)d; r.b = *(const f32x4*)(d + 4); return r; },
        [&](EPI_ARGS) {
        float* d = out + (size_t)row * DM + col; *(f32x4*)d = pv.a + lo; *(f32x4*)(d + 4) = pv.b + hi; }); } }
  }
  if constexpr (FUSED) { KParams P_ = kp; asm volatile("" : "+s"(P_)); xcd_barrier((unsigned*)(P_->ws + WS_BAR), xb_st, wave_s); }
  if constexpr ((MASK >> 12) & 1) { PHASE_PTRS
  rmsnorm_rows_f32_inplace(p.out, p.final_norm, wave_s);
  }
  }
}

constexpr int LDS_BYTES = LDS_MAIN + 16;

template <int MASK>
static bool launch_phase(const Params& p, int b, int grid, hipStream_t stream) {
  static bool attr_done = false;
  if (!attr_done) { attr_done = true;
    if (hipFuncSetAttribute((const void*)fwd_kernel<MASK>, hipFuncAttributeMaxDynamicSharedMemorySize, LDS_BYTES) != hipSuccess) { fprintf(stderr, "kernel_launch: hipFuncSetAttribute failed (mask %x)\n", MASK); return false; } }
  fwd_kernel<MASK><<<dim3(grid), dim3(512), LDS_BYTES, stream>>>(p, b);
  return true;
}

extern "C" void kernel_launch(void* const* d_in, const int* in_sizes, int n_in, void* d_out, int out_size, void* d_ws, size_t ws_size, hipStream_t stream) {
  static int grid_blocks = 0;
  if (grid_blocks == 0) {
    if (n_in != 15 || in_sizes[0] != T * DM || out_size != T * DM || ws_size < WS_END) {
      fprintf(stderr, "kernel_launch: shape/workspace mismatch (n_in %d, in0 %d, out %d, ws %zu, need %zu)\n", n_in, n_in > 0 ? in_sizes[0] : -1, out_size, ws_size, (size_t)WS_END);
      grid_blocks = -1; return; }
    int dev = 0, cus = 0, per_cu = 0;
    (void)hipGetDevice(&dev);
    (void)hipDeviceGetAttribute(&cus, hipDeviceAttributeMultiprocessorCount, dev);
#if N_LAUNCH_MODE == 0
    if (hipFuncSetAttribute((const void*)fwd_kernel<0x3fff>, hipFuncAttributeMaxDynamicSharedMemorySize, LDS_BYTES) != hipSuccess) { fprintf(stderr, "kernel_launch: hipFuncSetAttribute failed\n"); grid_blocks = -1; return; }
    if (hipOccupancyMaxActiveBlocksPerMultiprocessor(&per_cu, (const void*)fwd_kernel<0x3fff>, 512, LDS_BYTES) != hipSuccess || per_cu < 1) { fprintf(stderr, "kernel_launch: occupancy query failed (%d)\n", per_cu); grid_blocks = -1; return; }
#endif
    (void)per_cu;
    grid_blocks = cus;
  }
  if (grid_blocks < 0) return;
  Params p{};
  p.x = (const float*)d_in[0]; p.pos = (const int*)d_in[1];
  p.pool_norm = (const float*)d_in[2]; p.pool_w_in = (const float*)d_in[3]; p.pool_w_group = (const float*)d_in[4]; p.pool_scale = (const float*)d_in[5]; p.pool_w_out = (const float*)d_in[6];
  p.mla_norm = (const float*)d_in[7]; p.mla_w_in = (const float*)d_in[8]; p.mla_q_norm = (const float*)d_in[9]; p.mla_w_q_b = (const float*)d_in[10]; p.mla_kv_norm = (const float*)d_in[11];
  p.mla_w_kv_b = (const float*)d_in[12]; p.mla_w_out = (const float*)d_in[13]; p.final_norm = (const float*)d_in[14];
  p.out = (float*)d_out; p.ws = (unsigned char*)d_ws;
#if N_LAUNCH_MODE == 0
  if (hipMemsetAsync((char*)d_ws + WS_BAR, 0, XCD_BAR_WORDS * 4, stream) != hipSuccess) { fprintf(stderr, "kernel_launch: memset of the barrier word failed\n"); return; }
  int b0 = 0;
  void* args[] = {&p, &b0};
  hipError_t e = hipLaunchCooperativeKernel((const void*)fwd_kernel<0x3fff>, dim3(grid_blocks), dim3(512), args, LDS_BYTES, stream);
  if (e != hipSuccess) fprintf(stderr, "cooperative launch failed: %s (grid %d)\n", hipGetErrorString(e), grid_blocks);
#else
  const int g = grid_blocks;
  launch_phase<1 << 0>(p, 0, g, stream); launch_phase<1 << 1>(p, 0, g, stream); launch_phase<1 << 2>(p, 0, g, stream); launch_phase<1 << 3>(p, 0, g, stream);
  launch_phase<1 << 4>(p, 0, g, stream); launch_phase<1 << 6>(p, 0, g, stream);
  for (int b = 0; b < NB; ++b) { launch_phase<1 << 8>(p, b, g, stream); launch_phase<1 << 13>(p, b, g, stream); launch_phase<1 << 9>(p, b, g, stream); }
  launch_phase<1 << 10>(p, 0, g, stream); launch_phase<1 << 11>(p, 0, g, stream); launch_phase<1 << 12>(p, 0, g, stream);
#endif
}
```
